# Optimizing an MI355X kernel written in HIP

```python
import jax, jax.numpy as jnp
from jax import lax
import numpy as np


D_MODEL = 1024
BATCH = 16
SEQ = 2048
DEPTH = 2

N_MIXERS = 2
POOL_EXPAND = 2
D_POOL = POOL_EXPAND * D_MODEL
POOL_WINDOWS = (2, 4, 8, 16)
N_POOL_GROUPS = len(POOL_WINDOWS)
POOL_GROUP = D_POOL // N_POOL_GROUPS
HEAD_DIM = 64
N_HEADS = D_MODEL // HEAD_DIM
N_KV = 4
HPG = N_HEADS // N_KV
D_ATT = N_HEADS * HEAD_DIM
D_KV = N_KV * HEAD_DIM
N_BRANCH = 3
CMP_BLOCK = 32
CMP_STRIDE = 16
CMP_HIDDEN = 4 * HEAD_DIM
SEL_BLOCK = 64
SEL_TOPN = 8
WINDOW = 256
Q_BLOCK = 64
NSA_SPLITS = (D_ATT, D_KV, D_KV, D_KV, D_KV, D_KV, D_KV, D_ATT, N_BRANCH * N_HEADS)
NSA_VALUE_SLOTS = (2, 4, 6)
D_NSA_IN = sum(NSA_SPLITS)

N_POOL_LAYERS = (DEPTH + N_MIXERS - 1) // N_MIXERS
N_NSA_LAYERS = DEPTH // N_MIXERS

DN_ALPHA = (2.0 * DEPTH) ** 0.25
DN_BETA = (8.0 * DEPTH) ** -0.25
LN_EPS = 1e-5
NEG_INF = -1e30
FORCE_SCORE = 1e9

kernel_name = 'hybrid_pool_nsa_deepnorm'


def layer_norm(x, g, b):
    xf = x.astype(jnp.float32)
    mu = jnp.mean(xf, axis=-1, keepdims=True)
    var = jnp.mean(jnp.square(xf - mu), axis=-1, keepdims=True)
    y = (xf - mu) * lax.rsqrt(var + LN_EPS) * g.astype(jnp.float32) + b.astype(jnp.float32)
    return y.astype(x.dtype)


def alibi_slopes():
    h = jnp.arange(1, N_HEADS + 1, dtype=jnp.float32)
    return (2.0 ** (-8.0 * h / N_HEADS)).reshape(N_KV, HPG)


def masked_softmax(s, valid):
    p = jax.nn.softmax(jnp.where(valid, s, NEG_INF), axis=-1)
    return jnp.where(valid, p, 0.0)


def pool_mixer(x, w_in, w_grp, scale, w_out):
    B, S, _ = x.shape
    h = x @ w_in
    u, z = h[..., :D_POOL], h[..., D_POOL:]
    u = u.astype(jnp.float32).reshape(B, S, N_POOL_GROUPS, POOL_GROUP)
    csum = jnp.cumsum(u, axis=1)
    t = jnp.arange(S)
    outs = []
    for g, w in enumerate(POOL_WINDOWS):
        c = csum[:, :, g]
        lag = jnp.pad(c, ((0, 0), (w, 0), (0, 0)))[:, :S]
        cnt = jnp.minimum(t + 1, w).astype(jnp.float32)[None, :, None]
        outs.append((c - lag) / cnt - u[:, :, g])
    m = jnp.stack(outs, axis=2).astype(x.dtype)
    m = jnp.einsum('bsgc,gcd->bsgd', m, w_grp).reshape(B, S, D_POOL) * scale
    return (m * jax.nn.silu(z)) @ w_out


def nsa_mixer(x, w_in, pos_k, w1_k, w2_k, pos_v, w1_v, w2_v, w_out):
    B, S, _ = x.shape
    dt = x.dtype
    h = x @ w_in
    q, kc, vc, ks, vs, kw, vw, z, gl = jnp.split(h, np.cumsum(NSA_SPLITS)[:-1].tolist(), axis=-1)
    q = q.reshape(B, S, N_KV, HPG, HEAD_DIM) * (HEAD_DIM ** -0.5)
    kc, vc, ks, vs, kw, vw = [a.reshape(B, S, N_KV, HEAD_DIM) for a in (kc, vc, ks, vs, kw, vw)]
    gates = jax.nn.sigmoid(gl.astype(jnp.float32)).reshape(B, S, N_KV, HPG, N_BRANCH)
    slopes = alibi_slopes()[None, :, :, None, None]

    n_cmp = (S - CMP_BLOCK) // CMP_STRIDE + 1
    cmp_idx = np.arange(n_cmp)[:, None] * CMP_STRIDE + np.arange(CMP_BLOCK)[None, :]
    cmp_end = jnp.asarray(cmp_idx[:, -1], dtype=jnp.int32)

    def compress(a, pos, w1, w2):
        blk = a[:, cmp_idx] + pos[None, None, :, None, :]
        blk = blk.transpose(0, 1, 3, 2, 4).reshape(B, n_cmp, N_KV, CMP_BLOCK * HEAD_DIM)
        return jax.nn.silu(blk @ w1) @ w2

    k_cmp = compress(kc, pos_k, w1_k, w2_k)
    v_cmp = compress(vc, pos_v, w1_v, w2_v)

    n_sel = S // SEL_BLOCK
    top_n = min(SEL_TOPN, n_sel)
    c0 = np.arange(n_cmp)[:, None] * CMP_STRIDE
    j0 = np.arange(n_sel)[None, :] * SEL_BLOCK
    overlap = jnp.asarray((c0 < j0 + SEL_BLOCK) & (c0 + CMP_BLOCK > j0), dtype=jnp.float32)
    ks_blk = ks.reshape(B, n_sel, SEL_BLOCK, N_KV, HEAD_DIM).transpose(0, 3, 1, 2, 4)
    vs_blk = vs.reshape(B, n_sel, SEL_BLOCK, N_KV, HEAD_DIM).transpose(0, 3, 1, 2, 4)
    b_ix = jnp.arange(B)[:, None, None, None]
    g_ix = jnp.arange(N_KV)[None, :, None, None]
    blk_ids = jnp.arange(n_sel)
    in_blk = jnp.arange(SEL_BLOCK)

    kw_pad = jnp.pad(kw, ((0, 0), (WINDOW, 0), (0, 0), (0, 0)))
    vw_pad = jnp.pad(vw, ((0, 0), (WINDOW, 0), (0, 0), (0, 0)))
    win_off = jnp.arange(WINDOW + Q_BLOCK) - WINDOW

    def block(i):
        q0 = i * Q_BLOCK
        qb = lax.dynamic_slice_in_dim(q, q0, Q_BLOCK, axis=1)
        gb = lax.dynamic_slice_in_dim(gates, q0, Q_BLOCK, axis=1)
        t = q0 + jnp.arange(Q_BLOCK)

        dist = t[:, None] - cmp_end[None, :]
        s = jnp.einsum('bqghd,bcgd->bghqc', qb, k_cmp).astype(jnp.float32)
        s = s - slopes * dist.astype(jnp.float32)
        p_cmp = masked_softmax(s, dist >= 0)
        o_cmp = jnp.einsum('bghqc,bcgd->bqghd', p_cmp.astype(dt), v_cmp)

        imp = jnp.einsum('bghqc,cn->bgqn', p_cmp, overlap)
        cur = t // SEL_BLOCK
        forced = (blk_ids[None] == 0) | (blk_ids[None] == cur[:, None]) | (blk_ids[None] == cur[:, None] - 1)
        future = blk_ids[None] > cur[:, None]
        imp = jnp.where(forced, FORCE_SCORE, jnp.where(future, NEG_INF, imp))
        _, sel = lax.top_k(imp, top_n)
        k_g = ks_blk[b_ix, g_ix, sel].reshape(B, N_KV, Q_BLOCK, top_n * SEL_BLOCK, HEAD_DIM)
        v_g = vs_blk[b_ix, g_ix, sel].reshape(B, N_KV, Q_BLOCK, top_n * SEL_BLOCK, HEAD_DIM)
        pos = (sel[..., None] * SEL_BLOCK + in_blk).reshape(B, N_KV, Q_BLOCK, top_n * SEL_BLOCK)
        dist = t[None, None, :, None] - pos
        s = jnp.einsum('bqghd,bgqkd->bghqk', qb, k_g).astype(jnp.float32)
        s = s - slopes * dist[:, :, None].astype(jnp.float32)
        p = masked_softmax(s, (dist >= 0)[:, :, None])
        o_sel = jnp.einsum('bghqk,bgqkd->bqghd', p.astype(dt), v_g)

        kwb = lax.dynamic_slice_in_dim(kw_pad, q0, WINDOW + Q_BLOCK, axis=1)
        vwb = lax.dynamic_slice_in_dim(vw_pad, q0, WINDOW + Q_BLOCK, axis=1)
        spos = q0 + win_off
        dist = t[:, None] - spos[None, :]
        valid = (dist >= 0) & (dist < WINDOW) & (spos[None, :] >= 0)
        s = jnp.einsum('bqghd,bkgd->bghqk', qb, kwb).astype(jnp.float32)
        s = s - slopes * dist.astype(jnp.float32)
        p = masked_softmax(s, valid)
        o_win = jnp.einsum('bghqk,bkgd->bqghd', p.astype(dt), vwb)

        o = gb[..., 0:1] * o_cmp + gb[..., 1:2] * o_sel + gb[..., 2:3] * o_win
        return o.astype(dt).reshape(B, Q_BLOCK, D_ATT)

    o = lax.map(block, jnp.arange(S // Q_BLOCK))
    o = o.transpose(1, 0, 2, 3).reshape(B, S, D_ATT)
    return (o * jax.nn.silu(z)) @ w_out


def setup_inputs(seed: int = 0) -> dict:
    key = jax.random.key(seed)
    k = jax.random.split(key, 16)
    nA, nB = N_POOL_LAYERS, N_NSA_LAYERS

    def nrm(kk, shape, scale):
        return jax.random.normal(kk, shape, jnp.float32) * scale

    pool_col = jnp.asarray(np.concatenate([np.full(D_POOL, DN_BETA), np.ones(D_POOL)]), dtype=jnp.float32)
    nsa_col = jnp.asarray(np.concatenate([np.full(n, DN_BETA if s in NSA_VALUE_SLOTS else 1.0)
                                          for s, n in enumerate(NSA_SPLITS)]), dtype=jnp.float32)
    return {
        'x': nrm(k[0], (BATCH, SEQ, D_MODEL), 1.0),
        'ln_g': 1.0 + nrm(k[1], (DEPTH, D_MODEL), 0.02),
        'ln_b': nrm(k[2], (DEPTH, D_MODEL), 0.02),
        'pool_w_in': nrm(k[3], (nA, D_MODEL, 2 * D_POOL), D_MODEL ** -0.5) * pool_col,
        'pool_w_grp': nrm(k[4], (nA, N_POOL_GROUPS, POOL_GROUP, POOL_GROUP), POOL_GROUP ** -0.5),
        'pool_scale': 1.0 + nrm(k[5], (nA, D_POOL), 0.02),
        'pool_w_out': nrm(k[6], (nA, D_POOL, D_MODEL), D_POOL ** -0.5 * DN_BETA),
        'nsa_w_in': nrm(k[7], (nB, D_MODEL, D_NSA_IN), D_MODEL ** -0.5) * nsa_col,
        'nsa_cmp_pos_k': nrm(k[8], (nB, CMP_BLOCK, HEAD_DIM), 0.02),
        'nsa_cmp_w1_k': nrm(k[9], (nB, CMP_BLOCK * HEAD_DIM, CMP_HIDDEN), (CMP_BLOCK * HEAD_DIM) ** -0.5),
        'nsa_cmp_w2_k': nrm(k[10], (nB, CMP_HIDDEN, HEAD_DIM), CMP_HIDDEN ** -0.5),
        'nsa_cmp_pos_v': nrm(k[11], (nB, CMP_BLOCK, HEAD_DIM), 0.02),
        'nsa_cmp_w1_v': nrm(k[12], (nB, CMP_BLOCK * HEAD_DIM, CMP_HIDDEN), (CMP_BLOCK * HEAD_DIM) ** -0.5),
        'nsa_cmp_w2_v': nrm(k[13], (nB, CMP_HIDDEN, HEAD_DIM), CMP_HIDDEN ** -0.5),
        'nsa_w_out': nrm(k[14], (nB, D_ATT, D_MODEL), D_ATT ** -0.5 * DN_BETA),
    }


def reference(x, ln_g, ln_b, pool_w_in, pool_w_grp, pool_scale, pool_w_out,
              nsa_w_in, nsa_cmp_pos_k, nsa_cmp_w1_k, nsa_cmp_w2_k,
              nsa_cmp_pos_v, nsa_cmp_w1_v, nsa_cmp_w2_v, nsa_w_out):
    for i in range(DEPTH):
        j = i // N_MIXERS
        if i % N_MIXERS == 0:
            y = pool_mixer(x, pool_w_in[j], pool_w_grp[j], pool_scale[j], pool_w_out[j])
        else:
            y = nsa_mixer(x, nsa_w_in[j], nsa_cmp_pos_k[j], nsa_cmp_w1_k[j], nsa_cmp_w2_k[j],
                          nsa_cmp_pos_v[j], nsa_cmp_w1_v[j], nsa_cmp_w2_v[j], nsa_w_out[j])
        x = layer_norm(DN_ALPHA * x + y, ln_g[i], ln_b[i])
    return x
```

```cpp
#include <hip/hip_runtime.h>
#include <hip/hip_cooperative_groups.h>
#include <cstdio>
#include <cstdint>
namespace cg = cooperative_groups;

#ifndef MK_SINGLE
#define MK_SINGLE 0
#endif

#define LAS __attribute__((address_space(3)))
#define DI __device__ __forceinline__
typedef unsigned short bf16_t;
typedef short bf16x8 __attribute__((ext_vector_type(8)));
typedef short s16x4 __attribute__((ext_vector_type(4)));
typedef float f32x2 __attribute__((ext_vector_type(2)));
typedef float f32x4 __attribute__((ext_vector_type(4)));
typedef float f32x16 __attribute__((ext_vector_type(16)));
typedef unsigned u32x2 __attribute__((ext_vector_type(2)));
typedef unsigned u32x4 __attribute__((ext_vector_type(4)));
typedef __bf16 bf16x2_t __attribute__((ext_vector_type(2)));

constexpr int SEQ = 2048, NB = 16, DM = 1024, MTOK = NB * SEQ;
constexpr int DPOOL = 2048, NSA_IN = 3632, NSA_PAD = 3840;
constexpr int NCMP_PAD = 128;
constexpr float DN_ALPHA = 1.41421356237309515f;
constexpr float LN_EPS = 1e-5f;
constexpr float LOG2E = 1.4426950408889634f;

constexpr size_t MiB = 1u << 20;
constexpr size_t WS_WINB = 1 * MiB;
constexpr size_t WS_WZT  = 5 * MiB;
constexpr size_t WS_WGT  = 9 * MiB;
constexpr size_t WS_WCT  = 11 * MiB;
constexpr size_t WS_WPOT = 15 * MiB;
constexpr size_t WS_WNIT = 19 * MiB;
constexpr size_t WS_W1T  = 27 * MiB;
constexpr size_t WS_W2T  = 29 * MiB;
constexpr size_t WS_WNOT = 30 * MiB;
constexpr size_t WS_BIAS = 32 * MiB;
constexpr size_t WS_XB   = 40 * MiB;
constexpr size_t WS_XP   = 104 * MiB;
constexpr size_t WS_V    = 104 * MiB;
constexpr size_t WS_A    = 360 * MiB;
constexpr size_t WS_QB   = 232 * MiB;
constexpr size_t WS_SZN  = 296 * MiB;
constexpr size_t WS_KV   = 360 * MiB;
constexpr size_t WS_GATE = 456 * MiB;
constexpr size_t WS_HID  = 462 * MiB;
constexpr size_t WS_CMP  = 470 * MiB;
constexpr size_t WS_END  = 472 * MiB;

DI unsigned cvtpk(float lo, float hi) { f32x2 v = {lo, hi}; bf16x2_t b = __builtin_convertvector(v, bf16x2_t); return __builtin_bit_cast(unsigned, b); }
DI float bf_lo(unsigned u) { return __builtin_bit_cast(float, u << 16); }
DI float bf_hi(unsigned u) { return __builtin_bit_cast(float, u & 0xffff0000u); }
DI float fexp2(float x) { return __builtin_amdgcn_exp2f(x); }
DI float sigmoid_f(float v) { return __builtin_amdgcn_rcpf(1.f + fexp2(-v * LOG2E)); }
DI float silu_f(float v) { return v * sigmoid_f(v); }
DI float wave_sum(float v) {
#pragma unroll
    for (int o = 1; o < 64; o <<= 1) v += __shfl_xor(v, o);
    return v;
}
#define MFMA32(a, b, c) __builtin_amdgcn_mfma_f32_32x32x16_bf16((a), (b), (c), 0, 0, 0)

namespace pg8 {
constexpr int BM = 256, BK = 64, HALF = 128, HTB = HALF * BK * 2, STAGE_BYTES = 8 * HTB, NXCD = 8, WGM = 8;
DI int lds_byte(int r, int c) { const int st = (r >> 4) * 2 + (c >> 5), rr = r & 15, cc = c & 31, ob = rr * 64 + cc * 2; return st * 1024 + (ob ^ (((ob >> 9) & 1) << 5)); }
DI void stage_rc(int b, int& R, int& C) { const int st = b / 1024, sb = b % 1024, swz = sb ^ (((sb >> 9) & 1) << 5); R = (st >> 1) * 16 + swz / 64; C = (st & 1) * 32 + (swz % 64) / 2; }
DI int perm32(int rho) { const int n = rho >> 4, i = rho & 15; return 8 * (i >> 2) + 4 * n + (i & 3); }

struct Unit { const char* a; const char* b; int pm, pn; };
struct Geom { int K; unsigned lda, ldb; unsigned kstepA, kstepB; unsigned hstepA, hstepB; };

DI bool order_next(int nM, int nN, int G, int c, int i, int& pm, int& pn) {
    const int nwg = nM * nN; const long L = (long)i * G + c; if (L >= nwg) return false;
    int wgid = (int)L; { const int q = nwg / NXCD, r = nwg % NXCD, xcd = wgid % NXCD, off = wgid / NXCD; wgid = (xcd < r ? xcd * (q + 1) : r * (q + 1) + (xcd - r) * q) + off; }
    const int nig = WGM * nN, gid = wgid / nig, fm = gid * WGM, gsz = (nM - fm) < WGM ? (nM - fm) : WGM;
    pm = fm + ((wgid % nig) % gsz); pn = (wgid % nig) / gsz; return true;
}

template <class Epi, class Sched, bool ALIGN_EPI>
DI void gemm_phase(LAS unsigned char* lds, const Geom g, const Sched& S, const Epi& E) {
    const int tid = threadIdx.x, wid = __builtin_amdgcn_readfirstlane(tid >> 6), lane = tid & 63, wr = wid >> 2, wc = wid & 3, fr = lane & 15, fq = lane >> 4;
    const int nt = g.K / BK;
    unsigned voffA[2], voffB[2];
#pragma unroll
    for (int i = 0; i < 2; ++i) { int R, C; stage_rc(tid * 16 + i * 8192, R, C); const int Rb = (R & ~31) + perm32(R & 31);
        voffA[i] = (unsigned)(R * g.lda + C) * 2u; voffB[i] = (unsigned)(Rb * g.ldb + C) * 2u; }
    const size_t kA = g.kstepA, kB = g.kstepB, hA = g.hstepA, hB = g.hstepB;
    const unsigned ldsw = (unsigned)wid * 1024u;
    const int aoff = lds_byte(wr * 64 + fr, fq * 8), boff = lds_byte(wc * 32 + fr, fq * 8);
#define PG8_SA(b, h) (((b) * 2 + (h)) * HTB)
#define PG8_SB(b, h) ((4 + (b) * 2 + (h)) * HTB)
#define PG8_STAGE(bufoff, gbase, voff) do { _Pragma("unroll") for (int _i = 0; _i < 2; ++_i) \
        __builtin_amdgcn_global_load_lds((const unsigned*)((const char*)(gbase) + (voff)[_i]), (LAS unsigned*)(lds + (bufoff) + ldsw + _i * 8192), 16, 0, 0); } while (0)
#define PG8_LDA(dst, b, h) do { _Pragma("unroll") for (int m = 0; m < 4; ++m) _Pragma("unroll") for (int k = 0; k < 2; ++k) dst[m][k] = *(const LAS bf16x8*)(lds + PG8_SA(b, h) + aoff + m * 2048 + k * 1024); } while (0)
#define PG8_LDB(dst, b, h) do { _Pragma("unroll") for (int n = 0; n < 2; ++n) _Pragma("unroll") for (int k = 0; k < 2; ++k) dst[n][k] = *(const LAS bf16x8*)(lds + PG8_SB(b, h) + boff + n * 2048 + k * 1024); } while (0)
#define PG8_MMA(ai, bj, At, Bt) do { __builtin_amdgcn_s_setprio(1); _Pragma("unroll") for (int m = 0; m < 4; ++m) _Pragma("unroll") for (int n = 0; n < 2; ++n) _Pragma("unroll") for (int k = 0; k < 2; ++k) \
        acc[ai][bj][m][n] = __builtin_amdgcn_mfma_f32_16x16x32_bf16(Bt[n][k], At[m][k], acc[ai][bj][m][n], 0, 0, 0); __builtin_amdgcn_s_setprio(0); } while (0)
#define PG8_WAIT_V(n) asm volatile("s_waitcnt vmcnt(" #n ")" ::: "memory")
#define PG8_WAIT_L(n) asm volatile("s_waitcnt lgkmcnt(" #n ")" ::: "memory")
#define PG8_BAR __builtin_amdgcn_s_barrier()
#define PG8_SCHED __builtin_amdgcn_sched_barrier(0)
    Unit cur, nxt; int ui = 0;
    if (!S.next(0, cur)) return;
    f32x4 acc[2][2][4][2];
#pragma unroll
    for (int a = 0; a < 2; ++a)
#pragma unroll
        for (int b = 0; b < 2; ++b)
#pragma unroll
            for (int m = 0; m < 4; ++m)
#pragma unroll
                for (int n = 0; n < 2; ++n) acc[a][b][m][n] = (f32x4){0.f, 0.f, 0.f, 0.f};
    bf16x8 At[4][2], B0[2][2], B1[2][2];
    const char* cA = cur.a; const char* cB = cur.b;
    PG8_STAGE(PG8_SB(0, 0), cB, voffB); PG8_STAGE(PG8_SB(0, 1), cB + hB, voffB); PG8_STAGE(PG8_SA(0, 0), cA, voffA); PG8_STAGE(PG8_SA(0, 1), cA + hA, voffA);
    if (wr == 1) PG8_BAR;
    PG8_WAIT_V(2); PG8_BAR;
    PG8_STAGE(PG8_SB(1, 0), cB + kB, voffB); PG8_STAGE(PG8_SA(1, 0), cA + kA, voffA); PG8_STAGE(PG8_SB(1, 1), cB + hB + kB, voffB);
    PG8_WAIT_V(6); PG8_BAR;
    for (;;) {
        const bool has_next = S.next(ui + 1, nxt);
        const char* nA = has_next ? nxt.a : cA; const char* nB = has_next ? nxt.b : cB;
        for (int t = 0; t < nt; t += 2) {
            const bool last = (t == nt - 2);
            const char* a1 = cA + (size_t)(t + 1) * kA;
            const char* a2 = last ? nA : cA + (size_t)(t + 2) * kA; const char* b2 = last ? nB : cB + (size_t)(t + 2) * kB;
            const char* a3 = a2 + kA; const char* b3 = b2 + kB;
            PG8_LDB(B0, 0, 0); PG8_LDB(B1, 0, 1); PG8_SCHED; PG8_LDA(At, 0, 0); PG8_STAGE(PG8_SA(1, 1), a1 + hA, voffA);
            PG8_WAIT_V(8); PG8_WAIT_L(0); PG8_BAR; PG8_MMA(0, 0, At, B0); PG8_MMA(0, 1, At, B1); PG8_BAR; PG8_SCHED;
            PG8_LDA(At, 0, 1); PG8_STAGE(PG8_SB(0, 0), b2, voffB); PG8_STAGE(PG8_SB(0, 1), b2 + hB, voffB); PG8_STAGE(PG8_SA(0, 0), a2, voffA);
            PG8_WAIT_V(8); PG8_WAIT_L(0); PG8_BAR; PG8_MMA(1, 0, At, B0); PG8_MMA(1, 1, At, B1); PG8_BAR; PG8_SCHED;
            PG8_LDB(B0, 1, 0); PG8_LDB(B1, 1, 1); PG8_SCHED; PG8_LDA(At, 1, 0); PG8_STAGE(PG8_SA(0, 1), a2 + hA, voffA);
            PG8_WAIT_V(8); PG8_WAIT_L(0); PG8_BAR; PG8_MMA(0, 0, At, B0); PG8_MMA(0, 1, At, B1); PG8_BAR; PG8_SCHED;
            PG8_LDA(At, 1, 1); PG8_STAGE(PG8_SB(1, 0), b3, voffB); PG8_STAGE(PG8_SB(1, 1), b3 + hB, voffB); PG8_STAGE(PG8_SA(1, 0), a3, voffA);
            PG8_WAIT_V(8); PG8_WAIT_L(0); PG8_BAR; PG8_MMA(1, 0, At, B0); PG8_MMA(1, 1, At, B1); PG8_BAR; PG8_SCHED;
        }
        if constexpr (ALIGN_EPI) { if (wr == 0) PG8_BAR; }
        E(acc, cur, wr, wc, fr, fq);
        if (!has_next) break;
#pragma unroll
        for (int a = 0; a < 2; ++a)
#pragma unroll
            for (int b = 0; b < 2; ++b)
#pragma unroll
                for (int m = 0; m < 4; ++m)
#pragma unroll
                    for (int n = 0; n < 2; ++n) acc[a][b][m][n] = (f32x4){0.f, 0.f, 0.f, 0.f};
        cur = nxt; cA = nA; cB = nB; ++ui;
        if constexpr (ALIGN_EPI) { if (wr == 1) PG8_BAR; }
    }
    PG8_WAIT_V(0);
    if constexpr (!ALIGN_EPI) { if (wr == 0) PG8_BAR; }
    PG8_BAR;
#undef PG8_SA
#undef PG8_SB
#undef PG8_STAGE
#undef PG8_LDA
#undef PG8_LDB
#undef PG8_MMA
#undef PG8_WAIT_V
#undef PG8_WAIT_L
#undef PG8_BAR
#undef PG8_SCHED
}
}
using pg8::Unit;
typedef f32x4 Acc[2][2][4][2];

DI void st8_bf16(bf16_t* p, f32x4 v0, f32x4 v1) { u32x4 w; w.x = cvtpk(v0[0], v0[1]); w.y = cvtpk(v0[2], v0[3]); w.z = cvtpk(v1[0], v1[1]); w.w = cvtpk(v1[2], v1[3]); *(u32x4*)p = w; }

struct SchedPlain {
    int nM, nN, G, c; const char* A; const char* B; size_t atile, btile;
    DI bool next(int i, Unit& u) const { int pm, pn; if (!pg8::order_next(nM, nN, G, c, i, pm, pn)) return false; u.pm = pm; u.pn = pn; u.a = A + (size_t)pm * atile; u.b = B + (size_t)pn * btile; return true; }
};
struct SchedU {
    int nM, nN, G, c; const char* A; const char* B; size_t atile, btile, agroup;
    DI bool next(int i, Unit& u) const { int pm, pn; if (!pg8::order_next(nM, nN, G, c, i, pm, pn)) return false; u.pm = pm; u.pn = pn; u.a = A + (size_t)(pn >> 1) * agroup + (size_t)pm * atile; u.b = B + (size_t)pn * btile; return true; }
};
struct SchedWc {
    int G, c; const char* A; const char* B;
    DI bool next(int i, Unit& u) const { int pm, pn; if (!pg8::order_next(8, 4, G, c, i, pm, pn)) return false; u.pm = pm; u.pn = pn; u.a = A + (size_t)pm * (256 * 512 * 2); u.b = B + (size_t)pn * (256 * 2048 * 2) + (size_t)(pm >> 1) * 1024; return true; }
};
struct SchedCmp1 {
    int G, c; const char* KV; const char* W1;
    DI bool next(int i, Unit& u) const { int pm, pn; if (!pg8::order_next(64, 1, G, c, i, pm, pn)) return false; u.pm = pm; u.pn = 0;
        const int kv = pm >> 5, rt = pm & 31, b = rt >> 1, g0 = (rt & 1) * 2;
        u.a = KV + (size_t)kv * ((size_t)MTOK * 256 * 2) + ((size_t)b * SEQ * 256 + g0 * 64) * 2; u.b = W1 + (size_t)kv * (256 * 2048 * 2); return true; }
};
struct SchedCmp2 {
    int G, c; const char* H; const char* W2;
    DI bool next(int i, Unit& u) const { int pm, pn; if (!pg8::order_next(64, 1, G, c, i, pm, pn)) return false; u.pm = pm; u.pn = 0;
        u.a = H + (size_t)pm * (256 * 256 * 2); u.b = W2 + (size_t)(pm >> 5) * (256 * 256 * 2); return true; }
};

#define EPI_LOOP_ROWS for (int ai = 0; ai < 2; ++ai) for (int m = 0; m < 4; ++m)
struct EpiSilu {
    bf16_t* O; int ld;
    DI void operator()(const Acc& acc, const Unit& u, int wr, int wc, int fr, int fq) const {
        const int row0 = u.pm * 256 + wr * 64 + fr, col0 = u.pn * 256 + wc * 32 + 8 * fq;
#pragma unroll
        EPI_LOOP_ROWS { bf16_t* rp = O + (size_t)(row0 + ai * 128 + m * 16) * ld + col0;
#pragma unroll
            for (int bj = 0; bj < 2; ++bj) { f32x4 v0 = acc[ai][bj][m][0], v1 = acc[ai][bj][m][1];
#pragma unroll
                for (int e = 0; e < 4; ++e) { v0[e] = silu_f(v0[e]); v1[e] = silu_f(v1[e]); }
                st8_bf16(rp + bj * 128, v0, v1); } }
    }
};
struct EpiMulSz {
    bf16_t* O; const bf16_t* SZ; int ld;
    DI void operator()(const Acc& acc, const Unit& u, int wr, int wc, int fr, int fq) const {
        const int row0 = u.pm * 256 + wr * 64 + fr, col0 = u.pn * 256 + wc * 32 + 8 * fq;
#pragma unroll
        EPI_LOOP_ROWS { const size_t off = (size_t)(row0 + ai * 128 + m * 16) * ld + col0;
#pragma unroll
            for (int bj = 0; bj < 2; ++bj) { f32x4 v0 = acc[ai][bj][m][0], v1 = acc[ai][bj][m][1]; const u32x4 s = *(const u32x4*)(SZ + off + bj * 128);
                v0[0] *= bf_lo(s.x); v0[1] *= bf_hi(s.x); v0[2] *= bf_lo(s.y); v0[3] *= bf_hi(s.y); v1[0] *= bf_lo(s.z); v1[1] *= bf_hi(s.z); v1[2] *= bf_lo(s.w); v1[3] *= bf_hi(s.w);
                st8_bf16(O + off + bj * 128, v0, v1); } }
    }
};
struct EpiRes {
    float* O; const float* R;
    DI void operator()(const Acc& acc, const Unit& u, int wr, int wc, int fr, int fq) const {
        const int row0 = u.pm * 256 + wr * 64 + fr, col0 = u.pn * 256 + wc * 32 + 8 * fq;
#pragma unroll
        EPI_LOOP_ROWS { const size_t off = (size_t)(row0 + ai * 128 + m * 16) * DM + col0;
#pragma unroll
            for (int bj = 0; bj < 2; ++bj) { const f32x4 r0 = *(const f32x4*)(R + off + bj * 128), r1 = *(const f32x4*)(R + off + bj * 128 + 4);
                *(f32x4*)(O + off + bj * 128) = r0 * DN_ALPHA + acc[ai][bj][m][0]; *(f32x4*)(O + off + bj * 128 + 4) = r1 * DN_ALPHA + acc[ai][bj][m][1]; } }
    }
};
struct EpiWc {
    bf16_t* O; const float* scale;
    DI void operator()(const Acc& acc, const Unit& u, int wr, int wc, int fr, int fq) const {
        const int row0 = u.pm * 256 + wr * 64 + fr, col0 = u.pn * 256 + wc * 32 + 8 * fq;
#pragma unroll
        EPI_LOOP_ROWS { const int row = row0 + ai * 128 + m * 16; const float sc = scale[row];
#pragma unroll
            for (int bj = 0; bj < 2; ++bj) st8_bf16(O + (size_t)row * 1024 + col0 + bj * 128, acc[ai][bj][m][0] * sc, acc[ai][bj][m][1] * sc); }
    }
};
struct EpiNsaIn {
    bf16_t* Q; bf16_t* KV; bf16_t* SZ; float* GT;
    DI void operator()(const Acc& acc, const Unit& u, int wr, int wc, int fr, int fq) const {
        const int row0 = u.pm * 256 + wr * 64 + fr, cl0 = wc * 32 + 8 * fq, pn = u.pn;
        if (pn < 4 || (pn >= 10 && pn < 14)) {
            const bool isq = pn < 4; bf16_t* base = isq ? Q + pn * 256 : SZ + (pn - 10) * 256;
#pragma unroll
            EPI_LOOP_ROWS { bf16_t* rp = base + (size_t)(row0 + ai * 128 + m * 16) * 1024 + cl0;
#pragma unroll
                for (int bj = 0; bj < 2; ++bj) { f32x4 v0 = acc[ai][bj][m][0], v1 = acc[ai][bj][m][1];
                    if (isq) { v0 = v0 * (0.125f * LOG2E); v1 = v1 * (0.125f * LOG2E); }
                    else {
#pragma unroll
                        for (int e = 0; e < 4; ++e) { v0[e] = silu_f(v0[e]); v1[e] = silu_f(v1[e]); } }
                    st8_bf16(rp + bj * 128, v0, v1); } }
        } else if (pn < 10) {
            bf16_t* base = KV + (size_t)(pn - 4) * ((size_t)MTOK * 256);
#pragma unroll
            EPI_LOOP_ROWS { bf16_t* rp = base + (size_t)(row0 + ai * 128 + m * 16) * 256 + cl0;
#pragma unroll
                for (int bj = 0; bj < 2; ++bj) st8_bf16(rp + bj * 128, acc[ai][bj][m][0], acc[ai][bj][m][1]); }
        } else {
            if (cl0 < 48) {
#pragma unroll
                EPI_LOOP_ROWS { float* rp = GT + (size_t)(row0 + ai * 128 + m * 16) * 48 + cl0; f32x4 v0 = acc[ai][0][m][0], v1 = acc[ai][0][m][1];
#pragma unroll
                    for (int e = 0; e < 4; ++e) { v0[e] = sigmoid_f(v0[e]); v1[e] = sigmoid_f(v1[e]); }
                    *(f32x4*)rp = v0; *(f32x4*)(rp + 4) = v1; }
            }
        }
    }
};
struct EpiHid {
    bf16_t* O; const float* bias;
    DI void operator()(const Acc& acc, const Unit& u, int wr, int wc, int fr, int fq) const {
        const int row0 = u.pm * 256 + wr * 64 + fr, col0 = wc * 32 + 8 * fq; const float* bp = bias + (u.pm >> 5) * 256 + col0;
#pragma unroll
        for (int bj = 0; bj < 2; ++bj) { const f32x4 b0 = *(const f32x4*)(bp + bj * 128), b1 = *(const f32x4*)(bp + bj * 128 + 4);
#pragma unroll
            EPI_LOOP_ROWS { f32x4 v0 = acc[ai][bj][m][0] + b0, v1 = acc[ai][bj][m][1] + b1;
#pragma unroll
                for (int e = 0; e < 4; ++e) { v0[e] = silu_f(v0[e]); v1[e] = silu_f(v1[e]); }
                st8_bf16(O + (size_t)(row0 + ai * 128 + m * 16) * 256 + col0 + bj * 128, v0, v1); } }
    }
};
struct EpiCmp {
    bf16_t* O;
    DI void operator()(const Acc& acc, const Unit& u, int wr, int wc, int fr, int fq) const {
        if (wc >= 2) return;
        const int row0 = u.pm * 256 + wr * 64 + fr, col0 = wc * 32 + 8 * fq;
#pragma unroll
        EPI_LOOP_ROWS { const int row = row0 + ai * 128 + m * 16; f32x4 v0 = acc[ai][0][m][0], v1 = acc[ai][0][m][1];
            if ((row & 127) == 127) { v0 = (f32x4){0.f, 0.f, 0.f, 0.f}; v1 = v0; }
            st8_bf16(O + (size_t)row * 64 + col0, v0, v1); }
    }
};

struct Args { const float* in[15]; float* out; unsigned char* ws; int ph_lo, ph_hi; };
enum { I_X = 0, I_LNG, I_LNB, I_PWIN, I_PWGRP, I_PSCALE, I_PWOUT, I_NWIN, I_POSK, I_W1K, I_W2K, I_POSV, I_W1V, I_W2V, I_NWOUT };

DI void transpose_item(const float* W, int ldw, int Nsrc, int Npad, bf16_t* WT, int ldt, LAS float* scr, int item, int lane) {
    const int nblk = Npad / 32, kb = item / nblk, nb = item % nblk, k0 = 64 * kb, n0 = 32 * nb;
    const int nn = n0 + (lane & 31); const bool ok = nn < Nsrc;
#pragma unroll 8
    for (int i = 0; i < 32; ++i) { const int kk = 2 * i + (lane >> 5); scr[kk * 33 + (lane & 31)] = ok ? W[(size_t)(k0 + kk) * ldw + nn] : 0.f; }
    asm volatile("s_waitcnt lgkmcnt(0)" ::: "memory");
    const int c = lane & 7;
#pragma unroll
    for (int j = 0; j < 4; ++j) { const int n = (lane >> 3) + 8 * j; const LAS float* s = scr + (8 * c) * 33 + n;
        u32x4 o; o.x = cvtpk(s[0 * 33], s[1 * 33]); o.y = cvtpk(s[2 * 33], s[3 * 33]); o.z = cvtpk(s[4 * 33], s[5 * 33]); o.w = cvtpk(s[6 * 33], s[7 * 33]);
        *(u32x4*)(WT + (size_t)(n0 + n) * ldt + k0 + 8 * c) = o; }
    asm volatile("s_waitcnt lgkmcnt(0)" ::: "memory");
}

DI void phase_convert(const Args& a, LAS unsigned char* lds) {
    unsigned char* ws = a.ws;
    const int tid = threadIdx.x, lane = tid & 63, wave = __builtin_amdgcn_readfirstlane(tid >> 6);
    const int G = gridDim.x, gw = blockIdx.x * 8 + wave, NGW = G * 8;
    LAS float* scr = (LAS float*)(lds + wave * 16384);
    constexpr int J0 = 16 * 64, J1 = 32 * 32, J2 = 16 * 120, J3 = 32 * 8, J5 = 4 * 8, J7 = 16 * 32, J8 = 8 * 16;
    constexpr int NIT = J0 + J1 + J2 + 2 * J3 + 2 * J5 + J7 + 4 * J8;
    for (int it = gw; it < NIT; it += NGW) {
        int r = it;
        if (r < J0) { transpose_item(a.in[I_PWIN] + 2048, 4096, 2048, 2048, (bf16_t*)(ws + WS_WZT), 1024, scr, r, lane); continue; } r -= J0;
        if (r < J1) { transpose_item(a.in[I_PWOUT], 1024, 1024, 1024, (bf16_t*)(ws + WS_WPOT), 2048, scr, r, lane); continue; } r -= J1;
        if (r < J2) { transpose_item(a.in[I_NWIN], NSA_IN, NSA_IN, NSA_PAD, (bf16_t*)(ws + WS_WNIT), 1024, scr, r, lane); continue; } r -= J2;
        if (r < J3) { transpose_item(a.in[I_W1K], 256, 256, 256, (bf16_t*)(ws + WS_W1T), 2048, scr, r, lane); continue; } r -= J3;
        if (r < J3) { transpose_item(a.in[I_W1V], 256, 256, 256, (bf16_t*)(ws + WS_W1T) + 256 * 2048, 2048, scr, r, lane); continue; } r -= J3;
        if (r < J5) { transpose_item(a.in[I_W2K], 64, 64, 256, (bf16_t*)(ws + WS_W2T), 256, scr, r, lane); continue; } r -= J5;
        if (r < J5) { transpose_item(a.in[I_W2V], 64, 64, 256, (bf16_t*)(ws + WS_W2T) + 256 * 256, 256, scr, r, lane); continue; } r -= J5;
        if (r < J7) { transpose_item(a.in[I_NWOUT], 1024, 1024, 1024, (bf16_t*)(ws + WS_WNOT), 1024, scr, r, lane); continue; } r -= J7;
        { const int g = r / J8; r -= g * J8; transpose_item(a.in[I_PWGRP] + (size_t)g * 512 * 512, 512, 512, 512, (bf16_t*)(ws + WS_WGT) + (size_t)g * 512 * 512, 512, scr, r, lane); }
    }
    { const float* W = a.in[I_PWIN]; bf16_t* O = (bf16_t*)(ws + WS_WINB);
      for (int e = blockIdx.x * 512 + tid; e < 1024 * 512; e += G * 512) { const int k = e >> 9, c4 = (e & 511) * 4; const f32x4 v = *(const f32x4*)(W + (size_t)k * 4096 + c4);
          u32x2 o; o.x = cvtpk(v[0], v[1]); o.y = cvtpk(v[2], v[3]); *(u32x2*)(O + (size_t)k * 2048 + c4) = o; } }
    for (int wi = gw; wi < 64; wi += NGW) {
        const int kv = wi >> 5, n0 = (wi & 31) * 8, kk = lane >> 3, nn = lane & 7;
        const float* pos = a.in[kv ? I_POSV : I_POSK]; const float* w1 = a.in[kv ? I_W1V : I_W1K];
        float s = 0.f;
        for (int j = 0; j < 256; ++j) { const int k = kk + 8 * j; s += pos[k] * w1[(size_t)k * 256 + n0 + nn]; }
        s += __shfl_xor(s, 8); s += __shfl_xor(s, 16); s += __shfl_xor(s, 32);
        if (lane < 8) ((float*)(ws + WS_BIAS))[kv * 256 + n0 + nn] = s;
    }
}

DI void phase_pool(const Args& a, int blk, int nblk) {
    const float* X = a.in[I_X]; bf16_t* XB = (bf16_t*)(a.ws + WS_XB); bf16_t* XP = (bf16_t*)(a.ws + WS_XP);
    const int nitems = (MTOK / 16) * 256;
    for (int it = blk * 512 + threadIdx.x; it < nitems; it += nblk * 512) {
        const int chunk = it >> 8, c4 = (it & 255) * 4, t0 = chunk * 16, tl0 = t0 & (SEQ - 1);
        f32x4 P[32];
        P[0] = (f32x4){0.f, 0.f, 0.f, 0.f};
        const float* xp = X + (size_t)t0 * DM + c4;
#pragma unroll
        for (int j = 1; j < 32; ++j) { f32x4 v = (f32x4){0.f, 0.f, 0.f, 0.f}; if (j >= 16 || tl0 != 0) v = *(const f32x4*)(xp + (ptrdiff_t)(j - 16) * DM); P[j] = v; }
#pragma unroll
        for (int j = 1; j < 32; ++j) P[j] = P[j] + P[j - 1];
#pragma unroll
        for (int r = 0; r < 16; ++r) {
            const int idx = r + 16; const f32x4 xt = P[idx] - P[idx - 1]; const int tl = tl0 + r; const size_t off = (size_t)(t0 + r) * DM + c4;
            { u32x2 o; o.x = cvtpk(xt[0], xt[1]); o.y = cvtpk(xt[2], xt[3]); *(u32x2*)(XB + off) = o; }
#pragma unroll
            for (int g = 0; g < 4; ++g) { const int w = 2 << g; const int cnt = (tl + 1 < w) ? tl + 1 : w; const float inv = 1.f / (float)cnt;
                const f32x4 mv = (P[idx] - P[idx - w]) * inv - xt; u32x2 o; o.x = cvtpk(mv[0], mv[1]); o.y = cvtpk(mv[2], mv[3]);
                *(u32x2*)(XP + (size_t)g * ((size_t)MTOK * DM) + off) = o; }
        }
    }
}

DI void phase_ln(const float* V, float* O, bf16_t* OB, const float* gam, const float* bet) {
    const int lane = threadIdx.x & 63, wave = threadIdx.x >> 6; const int gw = blockIdx.x * 8 + wave, NGW = gridDim.x * 8;
    f32x4 gg[4], bb[4];
#pragma unroll
    for (int j = 0; j < 4; ++j) { gg[j] = *(const f32x4*)(gam + 4 * lane + 256 * j); bb[j] = *(const f32x4*)(bet + 4 * lane + 256 * j); }
    for (int m = gw; m < MTOK; m += NGW) {
        const float* vr = V + (size_t)m * DM + 4 * lane; f32x4 v[4]; float s = 0.f;
#pragma unroll
        for (int j = 0; j < 4; ++j) { v[j] = *(const f32x4*)(vr + 256 * j); s += (v[j][0] + v[j][1]) + (v[j][2] + v[j][3]); }
        const float mean = wave_sum(s) * (1.f / DM); float s2 = 0.f;
#pragma unroll
        for (int j = 0; j < 4; ++j) { v[j] = v[j] - mean; s2 += (v[j][0] * v[j][0] + v[j][1] * v[j][1]) + (v[j][2] * v[j][2] + v[j][3] * v[j][3]); }
        const float rstd = 1.f / sqrtf(wave_sum(s2) * (1.f / DM) + LN_EPS);
#pragma unroll
        for (int j = 0; j < 4; ++j) { const f32x4 y = v[j] * rstd * gg[j] + bb[j]; *(f32x4*)(O + (size_t)m * DM + 4 * lane + 256 * j) = y;
            if (OB) { u32x2 o; o.x = cvtpk(y[0], y[1]); o.y = cvtpk(y[2], y[3]); *(u32x2*)(OB + (size_t)m * DM + 4 * lane + 256 * j) = o; } }
    }
}

constexpr int A_KT = 0, A_KT_SZ = 64 * 144;
constexpr int A_VT = 2 * A_KT_SZ, A_VT_SZ = 64 * 136;
constexpr int A_KC = 36864;
constexpr int A_VC = A_KC + 128 * 144;
constexpr int A_IMP = 73728;
constexpr int A_TOT = A_IMP + 32768;
constexpr int A_SEL = A_TOT + 8192;
static_assert(A_VT + 2 * A_VT_SZ <= A_KC && A_VC + 64 * 264 <= A_IMP, "attention LDS map");
constexpr int NEGBITS = (int)0xF149F2CAu;
DI int crow(int i, int h) { return (i & 3) + 8 * (i >> 2) + 4 * h; }
DI bf16x8 pack8(const f32x16& x, int s) { u32x4 p; p.x = cvtpk(x[8 * s], x[8 * s + 1]); p.y = cvtpk(x[8 * s + 2], x[8 * s + 3]); p.z = cvtpk(x[8 * s + 4], x[8 * s + 5]); p.w = cvtpk(x[8 * s + 6], x[8 * s + 7]); return __builtin_bit_cast(bf16x8, p); }

DI void attn_item(LAS unsigned char* lds, const bf16_t* QB, const bf16_t* KV, const bf16_t* CMP, const bf16_t* SZN, const float* GT, bf16_t* AO, int b, int i, int g) {
    const int tid = threadIdx.x, lane = tid & 63, w = __builtin_amdgcn_readfirstlane(tid >> 6), hh = w >> 1, qh = w & 1, r = lane & 31, h = lane >> 5;
    const int ql = 32 * qh + r, tq = 64 * i + ql, head = 4 * g + hh;
    const size_t row = (size_t)b * SEQ + tq;
    const bf16_t* KS = KV + (size_t)2 * MTOK * 256; const bf16_t* VS = KV + (size_t)3 * MTOK * 256;
    const bf16_t* KW = KV + (size_t)4 * MTOK * 256; const bf16_t* VW = KV + (size_t)5 * MTOK * 256;
    { const bf16_t* kc = CMP + (size_t)((b * 4 + g) * 128) * 64; const bf16_t* vc = kc + (size_t)8192 * 64;
#pragma unroll
      for (int j = 0; j < 2; ++j) { const int e = tid + 512 * j;
          { const int key = e >> 3, ch = e & 7; const u32x4 v = *(const u32x4*)(kc + key * 64 + ch * 8); *(LAS u32x4*)(lds + A_KC + key * 144 + ch * 16) = v; }
          { const int key = e & 127, dc = e >> 7; const u32x4 v = *(const u32x4*)(vc + key * 64 + dc * 8); LAS bf16_t* d = (LAS bf16_t*)(lds + A_VC) + (dc * 8) * 132 + key;
            d[0 * 132] = (bf16_t)(v.x & 0xffff); d[1 * 132] = (bf16_t)(v.x >> 16); d[2 * 132] = (bf16_t)(v.y & 0xffff); d[3 * 132] = (bf16_t)(v.y >> 16);
            d[4 * 132] = (bf16_t)(v.z & 0xffff); d[5 * 132] = (bf16_t)(v.z >> 16); d[6 * 132] = (bf16_t)(v.w & 0xffff); d[7 * 132] = (bf16_t)(v.w >> 16); } }
      if (tid == 0) ((LAS unsigned*)(lds + A_SEL))[64] = 0u; }
    bf16x8 qf[4];
    { const bf16_t* qp = QB + row * 1024 + head * 64 + 8 * h;
#pragma unroll
      for (int s = 0; s < 4; ++s) qf[s] = *(const bf16x8*)(qp + 16 * s); }
    const float* gp = GT + row * 48 + head * 3; const float g0 = gp[0], g1 = gp[1], g2 = gp[2];
    const float slope2 = fexp2(-0.5f * (float)(head + 1)) * LOG2E;
    __syncthreads();
    f32x16 Oacc[2];
    {
        f32x16 S[4];
#pragma unroll
        for (int kb = 0; kb < 4; ++kb) {
#pragma unroll
            for (int e = 0; e < 16; ++e) S[kb][e] = 0.f;
#pragma unroll
            for (int s = 0; s < 4; ++s) { const bf16x8 kf = *(const LAS bf16x8*)(lds + A_KC + (kb * 32 + r) * 144 + (16 * s + 8 * h) * 2); S[kb] = MFMA32(kf, qf[s], S[kb]); }
        }
        float mx = -1e30f;
#pragma unroll
        for (int kb = 0; kb < 4; ++kb)
#pragma unroll
            for (int e = 0; e < 16; ++e) { const int c = 32 * kb + crow(e, h); const int dist = tq - (16 * c + 31); const float sv = S[kb][e] - slope2 * (float)dist;
                S[kb][e] = sv + __builtin_bit_cast(float, (dist >> 31) & NEGBITS); mx = fmaxf(mx, S[kb][e]); }
        mx = fmaxf(fmaxf(mx, __shfl_xor(mx, 32)), -1e20f);
        float l = 0.f;
#pragma unroll
        for (int kb = 0; kb < 4; ++kb)
#pragma unroll
            for (int e = 0; e < 16; ++e) { const float p = fexp2(S[kb][e] - mx); S[kb][e] = p; l += p; }
        l += __shfl_xor(l, 32);
        const float inv = l > 0.f ? 1.f / l : 0.f;
#pragma unroll
        for (int kb = 0; kb < 4; ++kb) S[kb] = S[kb] * inv;
        float Gs[16], pl[16];
#pragma unroll
        for (int kb = 0; kb < 4; ++kb)
#pragma unroll
            for (int ig = 0; ig < 4; ++ig) { Gs[kb * 4 + ig] = (S[kb][4 * ig] + S[kb][4 * ig + 1]) + (S[kb][4 * ig + 2] + S[kb][4 * ig + 3]); pl[kb * 4 + ig] = __shfl_xor(S[kb][4 * ig + 3], 32); }
        LAS float* imp = (LAS float*)(lds + A_IMP) + (hh * 64 + ql) * 32;
#pragma unroll
        for (int x = 0; x < 16; ++x) { const float prev = h ? pl[x] : (x > 0 ? pl[x > 0 ? x - 1 : 0] : 0.f); imp[8 * (x >> 2) + 2 * (x & 3) + h] = Gs[x] + prev; }
        f32x16 O[2];
#pragma unroll
        for (int dt = 0; dt < 2; ++dt)
#pragma unroll
            for (int e = 0; e < 16; ++e) O[dt][e] = 0.f;
#pragma unroll
        for (int kb = 0; kb < 4; ++kb)
#pragma unroll
            for (int s2 = 0; s2 < 2; ++s2) { const bf16x8 pb = pack8(S[kb], s2);
#pragma unroll
                for (int dt = 0; dt < 2; ++dt) { const LAS unsigned char* vp = lds + A_VC + (32 * dt + r) * 264 + (32 * kb + 16 * s2 + 4 * h) * 2;
                    const s16x4 lo = *(const LAS s16x4*)vp, hi = *(const LAS s16x4*)(vp + 16);
                    const bf16x8 vf = __builtin_shufflevector(lo, hi, 0, 1, 2, 3, 4, 5, 6, 7); O[dt] = MFMA32(vf, pb, O[dt]); } }
        Oacc[0] = O[0] * g0; Oacc[1] = O[1] * g0;
    }
    __syncthreads();
    {
        LAS float* IMP = (LAS float*)(lds + A_IMP); LAS float* TOT = (LAS float*)(lds + A_TOT); LAS unsigned* SEL = (LAS unsigned*)(lds + A_SEL);
        const int n = tid & 31;
#pragma unroll
        for (int ps = 0; ps < 4; ++ps) { const int q = ps * 16 + (tid >> 5);
            float v = (IMP[(0 * 64 + q) * 32 + n] + IMP[(1 * 64 + q) * 32 + n]) + (IMP[(2 * 64 + q) * 32 + n] + IMP[(3 * 64 + q) * 32 + n]);
            if (n == 0 || n == i || n == i - 1) v = 1e9f; else if (n > i) v = -1e30f;
            TOT[q * 32 + n] = v; }
        __syncthreads();
        unsigned uni = 0u;
#pragma unroll
        for (int ps = 0; ps < 4; ++ps) { const int q = ps * 16 + (tid >> 5); const float my = TOT[q * 32 + n]; int rank = 0;
#pragma unroll
            for (int j = 0; j < 8; ++j) { const f32x4 t4 = *(const LAS f32x4*)(TOT + q * 32 + 4 * j);
#pragma unroll
                for (int e = 0; e < 4; ++e) { const int n2 = 4 * j + e; rank += (t4[e] > my || (t4[e] == my && n2 < n)) ? 1 : 0; } }
            const unsigned long long bal = __ballot(rank < 8);
            const unsigned lo = (unsigned)bal, hi = (unsigned)(bal >> 32);
            if (lane == 0) SEL[q] = lo; if (lane == 32) SEL[q] = hi;
            uni |= lo | hi; }
        const unsigned allowed = (i >= 31) ? 0xffffffffu : ((2u << i) - 1u);
        if (lane == 0) atomicOr((unsigned*)(SEL + 64), uni & allowed);
        __syncthreads();
    }
    const unsigned uni = __builtin_amdgcn_readfirstlane(((LAS unsigned*)(lds + A_SEL))[64]);
    const unsigned selm = ((LAS unsigned*)(lds + A_SEL))[ql];
    int kind = 0, n = i - 4 < 0 ? 0 : i - 4, buf = 0;
    const int skey = tid >> 3, sch = tid & 7;
    const int vkey = tid & 63, vdc = tid >> 6;
    u32x4 kreg, vreg;
    { const size_t base = ((size_t)b * SEQ + 64 * n) * 256 + g * 64; kreg = *(const u32x4*)(KW + base + skey * 256 + sch * 8); vreg = *(const u32x4*)(VW + base + vkey * 256 + vdc * 8); }
    float mrun = -1e20f, lrun = 0.f; f32x16 O[2];
#pragma unroll
    for (int dt = 0; dt < 2; ++dt)
#pragma unroll
        for (int e = 0; e < 16; ++e) O[dt][e] = 0.f;
    for (;;) {
        { *(LAS u32x4*)(lds + A_KT + buf * A_KT_SZ + skey * 144 + sch * 16) = kreg;
          LAS bf16_t* d = (LAS bf16_t*)(lds + A_VT + buf * A_VT_SZ) + (vdc * 8) * 68 + vkey;
          d[0 * 68] = (bf16_t)(vreg.x & 0xffff); d[1 * 68] = (bf16_t)(vreg.x >> 16); d[2 * 68] = (bf16_t)(vreg.y & 0xffff); d[3 * 68] = (bf16_t)(vreg.y >> 16);
          d[4 * 68] = (bf16_t)(vreg.z & 0xffff); d[5 * 68] = (bf16_t)(vreg.z >> 16); d[6 * 68] = (bf16_t)(vreg.w & 0xffff); d[7 * 68] = (bf16_t)(vreg.w >> 16); }
        __syncthreads();
        int kind2 = kind, n2 = 0; bool has_next = true;
        if (kind == 0) { if (n < i) n2 = n + 1; else { kind2 = 1; n2 = __builtin_ctz(uni); } }
        else { const unsigned rem = uni & ~((2u << n) - 1u); if (rem == 0u) has_next = false; else n2 = __builtin_ctz(rem); }
        if (has_next) { const size_t base = ((size_t)b * SEQ + 64 * n2) * 256 + g * 64; const bf16_t* kp = kind2 ? KS : KW; const bf16_t* vp = kind2 ? VS : VW;
            kreg = *(const u32x4*)(kp + base + skey * 256 + sch * 8); vreg = *(const u32x4*)(vp + base + vkey * 256 + vdc * 8); }
        {
            f32x16 S[2]; const LAS unsigned char* kb_ = lds + A_KT + buf * A_KT_SZ;
#pragma unroll
            for (int kb = 0; kb < 2; ++kb) {
#pragma unroll
                for (int e = 0; e < 16; ++e) S[kb][e] = 0.f;
#pragma unroll
                for (int s = 0; s < 4; ++s) { const bf16x8 kf = *(const LAS bf16x8*)(kb_ + (kb * 32 + r) * 144 + (16 * s + 8 * h) * 2); S[kb] = MFMA32(kf, qf[s], S[kb]); }
            }
            const int bd = tq - 64 * n;
            const int inv0 = kind ? (int)((selm >> n) & 1u) - 1 : 0;
            const int wlim = kind ? 0x7fffffff : 255;
            float mx = -1e30f;
#pragma unroll
            for (int kb = 0; kb < 2; ++kb)
#pragma unroll
                for (int e = 0; e < 16; ++e) { const int dist = bd - (32 * kb + crow(e, h)); const int bad = ((dist | (wlim - dist)) >> 31) | inv0;
                    const float sv = S[kb][e] - slope2 * (float)dist; S[kb][e] = sv + __builtin_bit_cast(float, bad & NEGBITS); mx = fmaxf(mx, S[kb][e]); }
            mx = fmaxf(mx, __shfl_xor(mx, 32));
            const float mnew = fmaxf(mrun, mx), alpha = fexp2(mrun - mnew); mrun = mnew;
            float ls = 0.f;
#pragma unroll
            for (int kb = 0; kb < 2; ++kb)
#pragma unroll
                for (int e = 0; e < 16; ++e) { const float p = fexp2(S[kb][e] - mnew); S[kb][e] = p; ls += p; }
            lrun = lrun * alpha + ls;
            O[0] = O[0] * alpha; O[1] = O[1] * alpha;
            const LAS unsigned char* vb_ = lds + A_VT + buf * A_VT_SZ;
#pragma unroll
            for (int kb = 0; kb < 2; ++kb)
#pragma unroll
                for (int s2 = 0; s2 < 2; ++s2) { const bf16x8 pb = pack8(S[kb], s2);
#pragma unroll
                    for (int dt = 0; dt < 2; ++dt) { const LAS unsigned char* vp = vb_ + (32 * dt + r) * 136 + (32 * kb + 16 * s2 + 4 * h) * 2;
                        const s16x4 lo = *(const LAS s16x4*)vp, hi = *(const LAS s16x4*)(vp + 16);
                        const bf16x8 vf = __builtin_shufflevector(lo, hi, 0, 1, 2, 3, 4, 5, 6, 7); O[dt] = MFMA32(vf, pb, O[dt]); } }
        }
        if (!has_next || kind2 != kind) {
            const float lt = lrun + __shfl_xor(lrun, 32); const float sc = (kind ? g1 : g2) * (lt > 0.f ? 1.f / lt : 0.f);
            Oacc[0] = Oacc[0] + O[0] * sc; Oacc[1] = Oacc[1] + O[1] * sc;
            mrun = -1e20f; lrun = 0.f;
#pragma unroll
            for (int dt = 0; dt < 2; ++dt)
#pragma unroll
                for (int e = 0; e < 16; ++e) O[dt][e] = 0.f;
        }
        if (!has_next) break;
        kind = kind2; n = n2; buf ^= 1;
    }
#pragma unroll
    for (int dt = 0; dt < 2; ++dt)
#pragma unroll
        for (int ig = 0; ig < 4; ++ig) { const size_t off = row * 1024 + head * 64 + 32 * dt + 8 * ig + 4 * h; const u32x2 z = *(const u32x2*)(SZN + off);
            u32x2 o; o.x = cvtpk(Oacc[dt][4 * ig] * bf_lo(z.x), Oacc[dt][4 * ig + 1] * bf_hi(z.x)); o.y = cvtpk(Oacc[dt][4 * ig + 2] * bf_lo(z.y), Oacc[dt][4 * ig + 3] * bf_hi(z.y));
            *(u32x2*)(AO + off) = o; }
}

DI void phase_attn(const Args& a, LAS unsigned char* lds) {
    unsigned char* ws = a.ws; const int G = gridDim.x;
    const bf16_t* QB = (const bf16_t*)(ws + WS_QB); const bf16_t* KV = (const bf16_t*)(ws + WS_KV); const bf16_t* CMP = (const bf16_t*)(ws + WS_CMP);
    const bf16_t* SZN = (const bf16_t*)(ws + WS_SZN); const float* GT = (const float*)(ws + WS_GATE); bf16_t* AO = (bf16_t*)(ws + WS_XB);
    for (int k = 0;; ++k) {
        const long idx = (long)k * G + blockIdx.x; if (idx >= 2048) break;
        const int grp = (int)(idx >> 6), sub = (int)(idx & 63);
        const int per = G >> 6;
        int lvl = grp;
        if (per > 1 && (k & 1)) { const int base = (grp / per) * per; lvl = base + (per - 1 - (grp - base)); if (lvl > 31) lvl = grp; }
        const int i = 31 - lvl, b = sub >> 2, g = sub & 3;
        attn_item(lds, QB, KV, CMP, SZN, GT, AO, b, i, g);
    }
}

constexpr int LDS_BYTES = 147456;
constexpr int N_PHASES = 12;
__global__ void __launch_bounds__(512, 2) fwd_kernel(Args a) {
    extern __shared__ __attribute__((aligned(16))) unsigned char lds_raw[];
    LAS unsigned char* lds = (LAS unsigned char*)lds_raw;
    unsigned char* ws = a.ws; const int G = gridDim.x, bid = blockIdx.x;
    const int lo = a.ph_lo, hi = a.ph_hi;
#define IN(k) (lo <= (k) && (k) < hi)
#define SEAM(k) do { if (IN(k) && IN((k) + 1)) cg::this_grid().sync(); } while (0)
    const char* XB = (const char*)(ws + WS_XB);
    if (IN(0)) { phase_convert(a, lds); }
    SEAM(0);
    if (IN(1)) {
        const int nwc = G >= 64 ? 32 : (G > 1 ? G / 2 : 0);
        if (bid < nwc || nwc == 0) {
            const pg8::Geom g{512, 512, 2048, 128, 128, 128 * 512 * 2, 128 * 2048 * 2};
            SchedWc S{nwc ? nwc : G, bid, (const char*)(ws + WS_WGT), (const char*)(ws + WS_WINB)};
            EpiWc E{(bf16_t*)(ws + WS_WCT), a.in[I_PSCALE]};
            pg8::gemm_phase<EpiWc, SchedWc, false>(lds, g, S, E);
        }
        if (bid >= nwc) phase_pool(a, bid - nwc, G - nwc);
    }
    SEAM(1);
    if (IN(2)) {
        const pg8::Geom g{1024, 1024, 1024, 128, 128, 128 * 1024 * 2, 128 * 1024 * 2};
        SchedPlain S{MTOK / 256, 8, G, bid, XB, (const char*)(ws + WS_WZT), (size_t)256 * 1024 * 2, (size_t)256 * 1024 * 2};
        EpiSilu E{(bf16_t*)a.out, 2048};
        pg8::gemm_phase<EpiSilu, SchedPlain, true>(lds, g, S, E);
    }
    SEAM(2);
    if (IN(3)) {
        const pg8::Geom g{1024, 1024, 1024, 128, 128, 128 * 1024 * 2, 128 * 1024 * 2};
        SchedU S{MTOK / 256, 8, G, bid, (const char*)(ws + WS_XP), (const char*)(ws + WS_WCT), (size_t)256 * 1024 * 2, (size_t)256 * 1024 * 2, (size_t)MTOK * 1024 * 2};
        EpiMulSz E{(bf16_t*)(ws + WS_A), (const bf16_t*)a.out, 2048};
        pg8::gemm_phase<EpiMulSz, SchedU, true>(lds, g, S, E);
    }
    SEAM(3);
    if (IN(4)) {
        const pg8::Geom g{2048, 2048, 2048, 128, 128, 128 * 2048 * 2, 128 * 2048 * 2};
        SchedPlain S{MTOK / 256, 4, G, bid, (const char*)(ws + WS_A), (const char*)(ws + WS_WPOT), (size_t)256 * 2048 * 2, (size_t)256 * 2048 * 2};
        EpiRes E{(float*)(ws + WS_V), a.in[I_X]};
        pg8::gemm_phase<EpiRes, SchedPlain, true>(lds, g, S, E);
    }
    SEAM(4);
    if (IN(5)) phase_ln((const float*)(ws + WS_V), (float*)(ws + WS_V), (bf16_t*)(ws + WS_XB), a.in[I_LNG], a.in[I_LNB]);
    SEAM(5);
    if (IN(6)) {
        const pg8::Geom g{1024, 1024, 1024, 128, 128, 128 * 1024 * 2, 128 * 1024 * 2};
        SchedPlain S{MTOK / 256, NSA_PAD / 256, G, bid, XB, (const char*)(ws + WS_WNIT), (size_t)256 * 1024 * 2, (size_t)256 * 1024 * 2};
        EpiNsaIn E{(bf16_t*)(ws + WS_QB), (bf16_t*)(ws + WS_KV), (bf16_t*)(ws + WS_SZN), (float*)(ws + WS_GATE)};
        pg8::gemm_phase<EpiNsaIn, SchedPlain, true>(lds, g, S, E);
    }
    SEAM(6);
    if (IN(7)) {
        const pg8::Geom g{2048, 4096, 2048, 512, 128, 128, 128 * 2048 * 2};
        SchedCmp1 S{G, bid, (const char*)(ws + WS_KV), (const char*)(ws + WS_W1T)};
        EpiHid E{(bf16_t*)(ws + WS_HID), (const float*)(ws + WS_BIAS)};
        pg8::gemm_phase<EpiHid, SchedCmp1, false>(lds, g, S, E);
    }
    SEAM(7);
    if (IN(8)) {
        const pg8::Geom g{256, 256, 256, 128, 128, 128 * 256 * 2, 128 * 256 * 2};
        SchedCmp2 S{G, bid, (const char*)(ws + WS_HID), (const char*)(ws + WS_W2T)};
        EpiCmp E{(bf16_t*)(ws + WS_CMP)};
        pg8::gemm_phase<EpiCmp, SchedCmp2, false>(lds, g, S, E);
    }
    SEAM(8);
    if (IN(9)) phase_attn(a, lds);
    SEAM(9);
    if (IN(10)) {
        const pg8::Geom g{1024, 1024, 1024, 128, 128, 128 * 1024 * 2, 128 * 1024 * 2};
        SchedPlain S{MTOK / 256, 4, G, bid, XB, (const char*)(ws + WS_WNOT), (size_t)256 * 1024 * 2, (size_t)256 * 1024 * 2};
        EpiRes E{a.out, (const float*)(ws + WS_V)};
        pg8::gemm_phase<EpiRes, SchedPlain, true>(lds, g, S, E);
    }
    SEAM(10);
    if (IN(11)) phase_ln(a.out, a.out, nullptr, a.in[I_LNG] + DM, a.in[I_LNB] + DM);
#undef IN
#undef SEAM
}

extern "C" void kernel_launch(void* const* d_in, const int* in_sizes, int n_in, void* d_out, int out_size, void* d_ws, size_t ws_size, hipStream_t stream) {
    static int grid = 0;
    if (grid == 0) {
        if (n_in != 15 || out_size != MTOK * DM || ws_size < WS_END) { fprintf(stderr, "kernel_launch: unexpected problem shape (n_in %d, out %d, ws %zu)\n", n_in, out_size, ws_size); grid = -1; return; }
        int dev = 0, cus = 0, per_cu = 0;
        if (hipGetDevice(&dev) != hipSuccess || hipDeviceGetAttribute(&cus, hipDeviceAttributeMultiprocessorCount, dev) != hipSuccess) { grid = -1; return; }
        if (hipFuncSetAttribute((const void*)fwd_kernel, hipFuncAttributeMaxDynamicSharedMemorySize, LDS_BYTES) != hipSuccess) { fprintf(stderr, "kernel_launch: hipFuncSetAttribute failed\n"); grid = -1; return; }
        if (hipOccupancyMaxActiveBlocksPerMultiprocessor(&per_cu, (const void*)fwd_kernel, 512, LDS_BYTES) != hipSuccess || per_cu < 1) per_cu = 1;
        (void)hipGetLastError();
        grid = cus * per_cu;
    }
    if (grid < 0) return;
    Args a{};
    for (int i = 0; i < 15; ++i) a.in[i] = (const float*)d_in[i];
    a.out = (float*)d_out; a.ws = (unsigned char*)d_ws;
#if MK_SINGLE
    a.ph_lo = 0; a.ph_hi = N_PHASES;
    void* args[] = {&a};
    hipError_t e = hipLaunchCooperativeKernel((const void*)fwd_kernel, dim3(grid), dim3(512), args, LDS_BYTES, stream);
    if (e != hipSuccess) fprintf(stderr, "cooperative launch failed: %s (grid %d)\n", hipGetErrorString(e), grid);
#else
    for (int p = 0; p < N_PHASES; ++p) { a.ph_lo = p; a.ph_hi = p + 1; hipLaunchKernelGGL(fwd_kernel, dim3(grid), dim3(512), LDS_BYTES, stream, a); }
#endif
}
```

```cpp
#include <hip/hip_runtime.h>
#include <hip/hip_cooperative_groups.h>
#include <cstdio>
#include <cstdint>
namespace cg = cooperative_groups;

#ifndef REP_MASK
#define REP_MASK 0
#endif
#ifndef MK_SINGLE
#define MK_SINGLE 1
#endif

#define LAS __attribute__((address_space(3)))
#define DI __device__ __forceinline__
typedef unsigned short bf16_t;
typedef short bf16x8 __attribute__((ext_vector_type(8)));
typedef short s16x4 __attribute__((ext_vector_type(4)));
typedef float f32x2 __attribute__((ext_vector_type(2)));
typedef float f32x4 __attribute__((ext_vector_type(4)));
typedef float f32x16 __attribute__((ext_vector_type(16)));
typedef unsigned u32x2 __attribute__((ext_vector_type(2)));
typedef unsigned u32x4 __attribute__((ext_vector_type(4)));
typedef __bf16 bf16x2_t __attribute__((ext_vector_type(2)));

constexpr int SEQ = 2048, NB = 16, DM = 1024, MTOK = NB * SEQ;
constexpr int DPOOL = 2048, NSA_IN = 3632, NSA_PAD = 3840;
constexpr int NCMP_PAD = 128;
constexpr float DN_ALPHA = 1.41421356237309515f;
constexpr float LN_EPS = 1e-5f;
constexpr float LOG2E = 1.4426950408889634f;

constexpr size_t MiB = 1u << 20;
constexpr size_t WS_CTL  = 0;
constexpr size_t WS_WINB = 1 * MiB;
constexpr size_t WS_WZT  = 5 * MiB;
constexpr size_t WS_WGT  = 9 * MiB;
constexpr size_t WS_WCT  = 11 * MiB;
constexpr size_t WS_WPOT = 15 * MiB;
constexpr size_t WS_WNIT = 19 * MiB;
constexpr size_t WS_W1T  = 27 * MiB;
constexpr size_t WS_W2T  = 29 * MiB;
constexpr size_t WS_WNOT = 30 * MiB;
constexpr size_t WS_BIAS = 32 * MiB;
constexpr size_t WS_STATS = 34 * MiB;
constexpr size_t WS_GB   = 33 * MiB;
constexpr size_t WS_SF   = 39 * MiB;
constexpr size_t WS_PART = 38 * MiB;
constexpr size_t WS_XB   = 40 * MiB;
constexpr size_t WS_XP   = 104 * MiB;
constexpr size_t WS_V    = 104 * MiB;
constexpr size_t WS_A    = 360 * MiB;
constexpr size_t WS_QB   = 232 * MiB;
constexpr size_t WS_SZN  = 296 * MiB;
constexpr size_t WS_KV   = 360 * MiB;
constexpr size_t WS_GATE = 456 * MiB;
constexpr size_t WS_HID  = 462 * MiB;
constexpr size_t WS_CMP  = 470 * MiB;
constexpr size_t WS_END  = 472 * MiB;

DI unsigned cvtpk(float lo, float hi) { f32x2 v = {lo, hi}; bf16x2_t b = __builtin_convertvector(v, bf16x2_t); return __builtin_bit_cast(unsigned, b); }
DI float bf_lo(unsigned u) { return __builtin_bit_cast(float, u << 16); }
DI float bf_hi(unsigned u) { return __builtin_bit_cast(float, u & 0xffff0000u); }
DI float fexp2(float x) { return __builtin_amdgcn_exp2f(x); }
DI float sigmoid_f(float v) { return __builtin_amdgcn_rcpf(1.f + fexp2(-v * LOG2E)); }
DI float silu_f(float v) { return v * sigmoid_f(v); }
DI float wave_sum(float v) {
#pragma unroll
    for (int o = 1; o < 64; o <<= 1) v += __shfl_xor(v, o);
    return v;
}
#define MFMA32(a, b, c) __builtin_amdgcn_mfma_f32_32x32x16_bf16((a), (b), (c), 0, 0, 0)

namespace pg8 {
constexpr int BM = 256, BK = 64, HALF = 128, HTB = HALF * BK * 2, STAGE_BYTES = 8 * HTB, NXCD = 8, WGM = 8;
DI int lds_byte(int r, int c) { const int st = (r >> 4) * 2 + (c >> 5), rr = r & 15, cc = c & 31, ob = rr * 64 + cc * 2; return st * 1024 + (ob ^ (((ob >> 9) & 1) << 5)); }
DI void stage_rc(int b, int& R, int& C) { const int st = b / 1024, sb = b % 1024, swz = sb ^ (((sb >> 9) & 1) << 5); R = (st >> 1) * 16 + swz / 64; C = (st & 1) * 32 + (swz % 64) / 2; }
DI int perm32(int rho) { const int n = rho >> 4, i = rho & 15; return 8 * (i >> 2) + 4 * n + (i & 3); }

struct Unit { const char* a; const char* b; int pm, pn; };
struct Geom { int K; unsigned lda, ldb; unsigned kstepA, kstepB; unsigned hstepA, hstepB; };

DI bool order_next(int nM, int nN, int G, int c, int i, int& pm, int& pn) {
    const int nwg = nM * nN; const long L = (long)i * G + c; if (L >= nwg) return false;
    int wgid = (int)L; { const int q = nwg / NXCD, r = nwg % NXCD, xcd = wgid % NXCD, off = wgid / NXCD; wgid = (xcd < r ? xcd * (q + 1) : r * (q + 1) + (xcd - r) * q) + off; }
    const int nig = WGM * nN, gid = wgid / nig, fm = gid * WGM, gsz = (nM - fm) < WGM ? (nM - fm) : WGM;
    pm = fm + ((wgid % nig) % gsz); pn = (wgid % nig) / gsz; return true;
}

DI void order_map(int nM, int nN, int L, int& pm, int& pn) {
    const int nwg = nM * nN; int wgid = L; { const int q = nwg / NXCD, r = nwg % NXCD, xcd = wgid % NXCD, off = wgid / NXCD; wgid = (xcd < r ? xcd * (q + 1) : r * (q + 1) + (xcd - r) * q) + off; }
    const int nig = WGM * nN, gid = wgid / nig, fm = gid * WGM, gsz = (nM - fm) < WGM ? (nM - fm) : WGM;
    pm = fm + ((wgid % nig) % gsz); pn = (wgid % nig) / gsz;
}
template <class Epi, class Sched, bool ALIGN_EPI>
DI void gemm_phase(LAS unsigned char* lds, const Geom g, const Sched& S, const Epi& E) {
    const int tid = threadIdx.x, wid = __builtin_amdgcn_readfirstlane(tid >> 6), lane = tid & 63, wr = wid >> 2, wc = wid & 3, fr = lane & 15, fq = lane >> 4;
    const int nt = g.K / BK;
    unsigned voffA[2], voffB[2];
#pragma unroll
    for (int i = 0; i < 2; ++i) { int R, C; stage_rc(tid * 16 + i * 8192, R, C); const int Rb = (R & ~31) + perm32(R & 31);
        voffA[i] = (unsigned)(R * g.lda + C) * 2u; voffB[i] = (unsigned)(Rb * g.ldb + C) * 2u; }
    const size_t kA = g.kstepA, kB = g.kstepB, hA = g.hstepA, hB = g.hstepB;
    const unsigned ldsw = (unsigned)wid * 1024u;
    const int aoff = lds_byte(wr * 64 + fr, fq * 8), boff = lds_byte(wc * 32 + fr, fq * 8);
#define PG8_SA(b, h) (((b) * 2 + (h)) * HTB)
#define PG8_SB(b, h) ((4 + (b) * 2 + (h)) * HTB)
#define PG8_STAGE(bufoff, gbase, voff) do { _Pragma("unroll") for (int _i = 0; _i < 2; ++_i) \
        __builtin_amdgcn_global_load_lds((const unsigned*)((const char*)(gbase) + (voff)[_i]), (LAS unsigned*)(lds + (bufoff) + ldsw + _i * 8192), 16, 0, 0); } while (0)
#define PG8_LDA(dst, b, h) do { _Pragma("unroll") for (int m = 0; m < 4; ++m) _Pragma("unroll") for (int k = 0; k < 2; ++k) dst[m][k] = *(const LAS bf16x8*)(lds + PG8_SA(b, h) + aoff + m * 2048 + k * 1024); } while (0)
#define PG8_LDB(dst, b, h) do { _Pragma("unroll") for (int n = 0; n < 2; ++n) _Pragma("unroll") for (int k = 0; k < 2; ++k) dst[n][k] = *(const LAS bf16x8*)(lds + PG8_SB(b, h) + boff + n * 2048 + k * 1024); } while (0)
#define PG8_MMA(ai, bj, At, Bt) do { __builtin_amdgcn_s_setprio(1); _Pragma("unroll") for (int m = 0; m < 4; ++m) _Pragma("unroll") for (int n = 0; n < 2; ++n) _Pragma("unroll") for (int k = 0; k < 2; ++k) \
        acc[ai][bj][m][n] = __builtin_amdgcn_mfma_f32_16x16x32_bf16(Bt[n][k], At[m][k], acc[ai][bj][m][n], 0, 0, 0); __builtin_amdgcn_s_setprio(0); } while (0)
#define PG8_WAIT_V(n) asm volatile("s_waitcnt vmcnt(" #n ")" ::: "memory")
#define PG8_WAIT_L(n) asm volatile("s_waitcnt lgkmcnt(" #n ")" ::: "memory")
#define PG8_BAR __builtin_amdgcn_s_barrier()
#define PG8_SCHED __builtin_amdgcn_sched_barrier(0)
    Unit cur, nxt; int ui = 0;
    if (!S.next(0, cur)) return;
    f32x4 acc[2][2][4][2];
#pragma unroll
    for (int a = 0; a < 2; ++a)
#pragma unroll
        for (int b = 0; b < 2; ++b)
#pragma unroll
            for (int m = 0; m < 4; ++m)
#pragma unroll
                for (int n = 0; n < 2; ++n) acc[a][b][m][n] = (f32x4){0.f, 0.f, 0.f, 0.f};
    bf16x8 At[4][2], B0[2][2], B1[2][2];
    const char* cA = cur.a; const char* cB = cur.b;
    PG8_STAGE(PG8_SB(0, 0), cB, voffB); PG8_STAGE(PG8_SB(0, 1), cB + hB, voffB); PG8_STAGE(PG8_SA(0, 0), cA, voffA); PG8_STAGE(PG8_SA(0, 1), cA + hA, voffA);
    if (wr == 1) PG8_BAR;
    PG8_WAIT_V(2); PG8_BAR;
    PG8_STAGE(PG8_SB(1, 0), cB + kB, voffB); PG8_STAGE(PG8_SA(1, 0), cA + kA, voffA); PG8_STAGE(PG8_SB(1, 1), cB + hB + kB, voffB);
    PG8_WAIT_V(6); PG8_BAR;
    for (;;) {
        const bool has_next = S.next(ui + 1, nxt);
        const char* nA = has_next ? nxt.a : cA; const char* nB = has_next ? nxt.b : cB;
        for (int t = 0; t < nt; t += 2) {
            const bool last = (t == nt - 2);
            const char* a1 = cA + (size_t)(t + 1) * kA;
            const char* a2 = last ? nA : cA + (size_t)(t + 2) * kA; const char* b2 = last ? nB : cB + (size_t)(t + 2) * kB;
            const char* a3 = a2 + kA; const char* b3 = b2 + kB;
            PG8_LDB(B0, 0, 0); PG8_LDB(B1, 0, 1); PG8_SCHED; PG8_LDA(At, 0, 0); PG8_STAGE(PG8_SA(1, 1), a1 + hA, voffA);
            PG8_WAIT_V(8); PG8_WAIT_L(0); PG8_BAR; PG8_MMA(0, 0, At, B0); PG8_MMA(0, 1, At, B1); PG8_BAR; PG8_SCHED;
            PG8_LDA(At, 0, 1); PG8_STAGE(PG8_SB(0, 0), b2, voffB); PG8_STAGE(PG8_SB(0, 1), b2 + hB, voffB); PG8_STAGE(PG8_SA(0, 0), a2, voffA);
            PG8_WAIT_V(8); PG8_WAIT_L(0); PG8_BAR; PG8_MMA(1, 0, At, B0); PG8_MMA(1, 1, At, B1); PG8_BAR; PG8_SCHED;
            PG8_LDB(B0, 1, 0); PG8_LDB(B1, 1, 1); PG8_SCHED; PG8_LDA(At, 1, 0); PG8_STAGE(PG8_SA(0, 1), a2 + hA, voffA);
            PG8_WAIT_V(8); PG8_WAIT_L(0); PG8_BAR; PG8_MMA(0, 0, At, B0); PG8_MMA(0, 1, At, B1); PG8_BAR; PG8_SCHED;
            PG8_LDA(At, 1, 1); PG8_STAGE(PG8_SB(1, 0), b3, voffB); PG8_STAGE(PG8_SB(1, 1), b3 + hB, voffB); PG8_STAGE(PG8_SA(1, 0), a3, voffA);
            PG8_WAIT_V(8); PG8_WAIT_L(0); PG8_BAR; PG8_MMA(1, 0, At, B0); PG8_MMA(1, 1, At, B1); PG8_BAR; PG8_SCHED;
        }
        if constexpr (ALIGN_EPI) { if (wr == 0) PG8_BAR; }
        E(acc, cur, wr, wc, fr, fq);
        if (!has_next) break;
#pragma unroll
        for (int a = 0; a < 2; ++a)
#pragma unroll
            for (int b = 0; b < 2; ++b)
#pragma unroll
                for (int m = 0; m < 4; ++m)
#pragma unroll
                    for (int n = 0; n < 2; ++n) acc[a][b][m][n] = (f32x4){0.f, 0.f, 0.f, 0.f};
        cur = nxt; cA = nA; cB = nB; ++ui;
        if constexpr (ALIGN_EPI) { if (wr == 1) PG8_BAR; }
    }
    PG8_WAIT_V(0);
    if constexpr (!ALIGN_EPI) { if (wr == 0) PG8_BAR; }
    PG8_BAR;
#undef PG8_SA
#undef PG8_SB
#undef PG8_STAGE
#undef PG8_LDA
#undef PG8_LDB
#undef PG8_MMA
#undef PG8_WAIT_V
#undef PG8_WAIT_L
#undef PG8_BAR
#undef PG8_SCHED
}
}
using pg8::Unit;
typedef f32x4 Acc[2][2][4][2];

DI void st8_bf16(bf16_t* p, f32x4 v0, f32x4 v1) { u32x4 w; w.x = cvtpk(v0[0], v0[1]); w.y = cvtpk(v0[2], v0[3]); w.z = cvtpk(v1[0], v1[1]); w.w = cvtpk(v1[2], v1[3]); *(u32x4*)p = w; }

struct SchedPlain {
    int nM, nN, G, c; const char* A; const char* B; size_t atile, btile;
    DI bool next(int i, Unit& u) const { int pm, pn; if (!pg8::order_next(nM, nN, G, c, i, pm, pn)) return false; u.pm = pm; u.pn = pn; u.a = A + (size_t)pm * atile; u.b = B + (size_t)pn * btile; return true; }
};
struct SchedU {
    int nM, nN, G, c; const char* A; const char* B; size_t atile, btile, agroup;
    DI bool next(int i, Unit& u) const { int pm, pn; if (!pg8::order_next(nM, nN, G, c, i, pm, pn)) return false; u.pm = pm; u.pn = pn; u.a = A + (size_t)(pn >> 1) * agroup + (size_t)pm * atile; u.b = B + (size_t)pn * btile; return true; }
};
struct SchedNsaA {
    int G, c; const char* A; const char* B;
    DI bool next(int i, Unit& u) const { int pm, pn; if (!pg8::order_next(MTOK / 256, 2, G, c, i, pm, pn)) return false; u.pm = pm; u.pn = pn + 4; u.a = A + (size_t)pm * (256 * 1024 * 2); u.b = B + (size_t)(pn + 4) * (256 * 1024 * 2); return true; }
};
struct SchedNsaB {
    int c; const char* A; const char* B;
    DI bool next(int i, Unit& u) const {
        int L;
        if (c < 64) { if (i >= 5) return false; L = i * 256 + c; }
        else if (c < 192) { if (i < 6) L = i * 256 + c; else if (i == 6) L = 1536 + (c - 64); else return false; }
        else { if (i < 6) L = i * 256 + c; else if (i == 6) L = 1280 + (c - 192); else return false; }
        int pm, pn; pg8::order_map(MTOK / 256, 13, L, pm, pn); pn = pn < 4 ? pn : pn + 2;
        u.pm = pm; u.pn = pn; u.a = A + (size_t)pm * (256 * 1024 * 2); u.b = B + (size_t)pn * (256 * 1024 * 2); return true; }
};
struct SchedZU {
    int G, c; const char* XBp; const char* XPp; const char* WZ; const char* WC;
    DI bool next(int i, Unit& u) const { int pm, pn; if (!pg8::order_next(MTOK / 256, 8, G, c, i >> 1, pm, pn)) return false; u.pm = pm;
        if ((i & 1) == 0) { u.pn = pn + 8; u.a = XBp + (size_t)pm * (256 * 1024 * 2); u.b = WZ + (size_t)pn * (256 * 1024 * 2); }
        else { u.pn = pn; u.a = XPp + (size_t)(pn >> 1) * ((size_t)MTOK * 1024 * 2) + (size_t)pm * (256 * 1024 * 2); u.b = WC + (size_t)pn * (256 * 1024 * 2); }
        return true; }
};
struct SchedWc {
    int G, c; const char* A; const char* B;
    DI bool next(int i, Unit& u) const { int pm, pn; if (!pg8::order_next(8, 4, G, c, i, pm, pn)) return false; u.pm = pm; u.pn = pn; u.a = A + (size_t)pm * (256 * 512 * 2); u.b = B + (size_t)pn * (256 * 2048 * 2) + (size_t)(pm >> 1) * 1024; return true; }
};
struct SchedCmp1 {
    int G, c; const char* KV; const char* W1;
    DI bool next(int i, Unit& u) const { int pm, pn; if (!pg8::order_next(64, 1, G, c, i, pm, pn)) return false; u.pm = pm; u.pn = 0;
        const int kv = pm >> 5, rt = pm & 31, b = rt >> 1, g0 = (rt & 1) * 2;
        u.a = KV + (size_t)kv * ((size_t)MTOK * 256 * 2) + ((size_t)b * SEQ * 256 + g0 * 64) * 2; u.b = W1 + (size_t)kv * (256 * 2048 * 2); return true; }
};
struct SchedCmp2 {
    int G, c; const char* H; const char* W2;
    DI bool next(int i, Unit& u) const { int pm, pn; if (!pg8::order_next(64, 1, G, c, i, pm, pn)) return false; u.pm = pm; u.pn = 0;
        u.a = H + (size_t)pm * (256 * 256 * 2); u.b = W2 + (size_t)(pm >> 5) * (256 * 256 * 2); return true; }
};

#define EPI_LOOP_ROWS for (int ai = 0; ai < 2; ++ai) for (int m = 0; m < 4; ++m)
struct EpiSilu {
    bf16_t* O; int ld;
    DI void operator()(const Acc& acc, const Unit& u, int wr, int wc, int fr, int fq) const {
        const int row0 = u.pm * 256 + wr * 64 + fr, col0 = u.pn * 256 + wc * 32 + 8 * fq;
#pragma unroll
        EPI_LOOP_ROWS { bf16_t* rp = O + (size_t)(row0 + ai * 128 + m * 16) * ld + col0;
#pragma unroll
            for (int bj = 0; bj < 2; ++bj) { f32x4 v0 = acc[ai][bj][m][0], v1 = acc[ai][bj][m][1];
#pragma unroll
                for (int e = 0; e < 4; ++e) { v0[e] = silu_f(v0[e]); v1[e] = silu_f(v1[e]); }
                st8_bf16(rp + bj * 128, v0, v1); } }
    }
};
struct EpiMulSz {
    bf16_t* O; const bf16_t* SZ; int ld;
    DI void operator()(const Acc& acc, const Unit& u, int wr, int wc, int fr, int fq) const {
        const int row0 = u.pm * 256 + wr * 64 + fr, col0 = u.pn * 256 + wc * 32 + 8 * fq;
#pragma unroll
        EPI_LOOP_ROWS { const size_t off = (size_t)(row0 + ai * 128 + m * 16) * ld + col0;
#pragma unroll
            for (int bj = 0; bj < 2; ++bj) { f32x4 v0 = acc[ai][bj][m][0], v1 = acc[ai][bj][m][1]; const u32x4 s = *(const u32x4*)(SZ + off + bj * 128);
                v0[0] *= bf_lo(s.x); v0[1] *= bf_hi(s.x); v0[2] *= bf_lo(s.y); v0[3] *= bf_hi(s.y); v1[0] *= bf_lo(s.z); v1[1] *= bf_hi(s.z); v1[2] *= bf_lo(s.w); v1[3] *= bf_hi(s.w);
                st8_bf16(O + off + bj * 128, v0, v1); } }
    }
};
DI void row_stats(const float* SF, int row, float& mean, float& rstd) { const f32x2 t = *(const f32x2*)(SF + (size_t)row * 2); mean = t[0]; rstd = t[1]; }
struct EpiZU {
    bf16_t* O; bf16_t* SZ;
    DI void operator()(const Acc& acc, const Unit& u, int wr, int wc, int fr, int fq) const {
        const bool isz = u.pn >= 8; const int row0 = u.pm * 256 + wr * 64 + fr, col0 = (isz ? u.pn - 8 : u.pn) * 256 + wc * 32 + 8 * fq;
        if (isz) {
#pragma unroll
            EPI_LOOP_ROWS { bf16_t* rp = SZ + (size_t)(row0 + ai * 128 + m * 16) * 2048 + col0;
#pragma unroll
                for (int bj = 0; bj < 2; ++bj) { f32x4 v0 = acc[ai][bj][m][0], v1 = acc[ai][bj][m][1];
#pragma unroll
                    for (int e = 0; e < 4; ++e) { v0[e] = silu_f(v0[e]); v1[e] = silu_f(v1[e]); }
                    st8_bf16(rp + bj * 128, v0, v1); } }
        } else {
            u32x4 zz[2][4][2];
#pragma unroll
            EPI_LOOP_ROWS {
#pragma unroll
                for (int bj = 0; bj < 2; ++bj) zz[ai][m][bj] = *(const u32x4*)(SZ + (size_t)(row0 + ai * 128 + m * 16) * 2048 + col0 + bj * 128); }
            __builtin_amdgcn_sched_barrier(0);
#pragma unroll
            EPI_LOOP_ROWS { const size_t off = (size_t)(row0 + ai * 128 + m * 16) * 2048 + col0;
#pragma unroll
                for (int bj = 0; bj < 2; ++bj) { f32x4 v0 = acc[ai][bj][m][0], v1 = acc[ai][bj][m][1]; const u32x4 z = zz[ai][m][bj];
                    v0[0] *= bf_lo(z.x); v0[1] *= bf_hi(z.x); v0[2] *= bf_lo(z.y); v0[3] *= bf_hi(z.y); v1[0] *= bf_lo(z.z); v1[1] *= bf_hi(z.z); v1[2] *= bf_lo(z.w); v1[3] *= bf_hi(z.w);
                    st8_bf16(O + off + bj * 128, v0, v1); } }
        }
    }
};
struct EpiRes0 {
    float* O; bf16_t* OB; const float* R; float* ST;
    DI void operator()(const Acc& acc, const Unit& u, int wr, int wc, int fr, int fq) const {
        const int row0 = u.pm * 256 + wr * 64 + fr, col0 = u.pn * 256 + wc * 32 + 8 * fq;
#pragma unroll
        for (int ai = 0; ai < 2; ++ai) {
            f32x4 xr[4][2][2];
#pragma unroll
            for (int m = 0; m < 4; ++m)
#pragma unroll
                for (int bj = 0; bj < 2; ++bj) { const float* rp = R + (size_t)(row0 + ai * 128 + m * 16) * DM + col0 + bj * 128;
                    xr[m][bj][0] = __builtin_nontemporal_load((const f32x4*)rp); xr[m][bj][1] = __builtin_nontemporal_load((const f32x4*)(rp + 4)); }
            __builtin_amdgcn_sched_barrier(0);
#pragma unroll
            for (int m = 0; m < 4; ++m) { const int row = row0 + ai * 128 + m * 16; const size_t off = (size_t)row * DM + col0; float s = 0.f, q = 0.f;
#pragma unroll
                for (int bj = 0; bj < 2; ++bj) {
                    const f32x4 v0 = xr[m][bj][0] * DN_ALPHA + acc[ai][bj][m][0], v1 = xr[m][bj][1] * DN_ALPHA + acc[ai][bj][m][1];
                    __builtin_nontemporal_store(v0, (f32x4*)(O + off + bj * 128)); __builtin_nontemporal_store(v1, (f32x4*)(O + off + bj * 128 + 4)); st8_bf16(OB + off + bj * 128, v0, v1);
                    s += ((v0[0] + v0[1]) + (v0[2] + v0[3])) + ((v1[0] + v1[1]) + (v1[2] + v1[3]));
                    q += ((v0[0] * v0[0] + v0[1] * v0[1]) + (v0[2] * v0[2] + v0[3] * v0[3])) + ((v1[0] * v1[0] + v1[1] * v1[1]) + (v1[2] * v1[2] + v1[3] * v1[3])); }
                s += __shfl_xor(s, 16); q += __shfl_xor(q, 16); s += __shfl_xor(s, 32); q += __shfl_xor(q, 32);
                if (fq == 0) { f32x2 o = {s, q}; *(f32x2*)(ST + (size_t)row * 32 + (u.pn * 4 + wc) * 2) = o; } }
        }
    }
};
struct EpiBf16 {
    bf16_t* O;
    DI void operator()(const Acc& acc, const Unit& u, int wr, int wc, int fr, int fq) const {
        const int row0 = u.pm * 256 + wr * 64 + fr, col0 = u.pn * 256 + wc * 32 + 8 * fq;
#pragma unroll
        EPI_LOOP_ROWS { bf16_t* rp = O + (size_t)(row0 + ai * 128 + m * 16) * DM + col0;
#pragma unroll
            for (int bj = 0; bj < 2; ++bj) st8_bf16(rp + bj * 128, acc[ai][bj][m][0], acc[ai][bj][m][1]); }
    }
};
struct EpiRes1 {
    float* O; const float* V; const float* SF; const float* gam; const float* bet;
    DI void operator()(const Acc& acc, const Unit& u, int wr, int wc, int fr, int fq) const {
        const int row0 = u.pm * 256 + wr * 64 + fr, col0 = u.pn * 256 + wc * 32 + 8 * fq;
        f32x4 g[2][2], bt[2][2];
#pragma unroll
        for (int bj = 0; bj < 2; ++bj) { const int c = col0 + bj * 128; g[bj][0] = *(const f32x4*)(gam + c); g[bj][1] = *(const f32x4*)(gam + c + 4); bt[bj][0] = *(const f32x4*)(bet + c); bt[bj][1] = *(const f32x4*)(bet + c + 4); }
#pragma unroll
        EPI_LOOP_ROWS { const int row = row0 + ai * 128 + m * 16; float mean, rstd; row_stats(SF, row, mean, rstd);
#pragma unroll
            for (int bj = 0; bj < 2; ++bj) { const size_t off = (size_t)row * DM + col0 + bj * 128;
                const f32x4 r0 = *(const f32x4*)(V + off), r1 = *(const f32x4*)(V + off + 4);
                const f32x4 x0 = (r0 - mean) * rstd * g[bj][0] + bt[bj][0], x1 = (r1 - mean) * rstd * g[bj][1] + bt[bj][1];
                *(f32x4*)(O + off) = x0 * DN_ALPHA + acc[ai][bj][m][0]; *(f32x4*)(O + off + 4) = x1 * DN_ALPHA + acc[ai][bj][m][1]; } }
    }
};
struct EpiWc {
    bf16_t* O; const float* scale;
    DI void operator()(const Acc& acc, const Unit& u, int wr, int wc, int fr, int fq) const {
        const int row0 = u.pm * 256 + wr * 64 + fr, col0 = u.pn * 256 + wc * 32 + 8 * fq;
#pragma unroll
        EPI_LOOP_ROWS { const int row = row0 + ai * 128 + m * 16; const float sc = scale[row];
#pragma unroll
            for (int bj = 0; bj < 2; ++bj) st8_bf16(O + (size_t)row * 1024 + col0 + bj * 128, acc[ai][bj][m][0] * sc, acc[ai][bj][m][1] * sc); }
    }
};
struct EpiNsaIn {
    bf16_t* Q; bf16_t* KV; bf16_t* SZ; float* GT; const float* SF; const float* GB;
    DI void operator()(const Acc& acc, const Unit& u, int wr, int wc, int fr, int fq) const {
        const int row0 = u.pm * 256 + wr * 64 + fr, cl0 = wc * 32 + 8 * fq, pn = u.pn;
        if (pn == 14 && cl0 >= 48) return;
        f32x4 Gv[2][2], Bv[2][2];
#pragma unroll
        for (int bj = 0; bj < 2; ++bj) { const int c = pn * 256 + bj * 128 + cl0; Gv[bj][0] = *(const f32x4*)(GB + c); Gv[bj][1] = *(const f32x4*)(GB + c + 4); Bv[bj][0] = *(const f32x4*)(GB + NSA_PAD + c); Bv[bj][1] = *(const f32x4*)(GB + NSA_PAD + c + 4); }
        f32x2 stt[2][4];
#pragma unroll
        EPI_LOOP_ROWS stt[ai][m] = *(const f32x2*)(SF + (size_t)(row0 + ai * 128 + m * 16) * 2);
        __builtin_amdgcn_sched_barrier(0);
#pragma unroll
        EPI_LOOP_ROWS { const int row = row0 + ai * 128 + m * 16; const float mean = stt[ai][m][0], rstd = stt[ai][m][1];
#pragma unroll
            for (int bj = 0; bj < 2; ++bj) {
                if (pn == 14 && bj == 1) break;
                f32x4 v0 = (acc[ai][bj][m][0] - Gv[bj][0] * mean) * rstd + Bv[bj][0], v1 = (acc[ai][bj][m][1] - Gv[bj][1] * mean) * rstd + Bv[bj][1];
                if (pn < 4) { v0 = v0 * (0.125f * LOG2E); v1 = v1 * (0.125f * LOG2E); st8_bf16(Q + (size_t)row * 1024 + pn * 256 + bj * 128 + cl0, v0, v1); }
                else if (pn < 10) { st8_bf16(KV + (size_t)(pn - 4) * ((size_t)MTOK * 256) + (size_t)row * 256 + bj * 128 + cl0, v0, v1); }
                else if (pn < 14) {
#pragma unroll
                    for (int e = 0; e < 4; ++e) { v0[e] = silu_f(v0[e]); v1[e] = silu_f(v1[e]); }
                    st8_bf16(SZ + (size_t)row * 1024 + (pn - 10) * 256 + bj * 128 + cl0, v0, v1); }
                else {
#pragma unroll
                    for (int e = 0; e < 4; ++e) { v0[e] = sigmoid_f(v0[e]); v1[e] = sigmoid_f(v1[e]); }
                    float* rp = GT + (size_t)row * 48 + cl0; *(f32x4*)rp = v0; *(f32x4*)(rp + 4) = v1; } } }
    }
};
struct EpiHid {
    bf16_t* O; const float* bias;
    DI void operator()(const Acc& acc, const Unit& u, int wr, int wc, int fr, int fq) const {
        const int row0 = u.pm * 256 + wr * 64 + fr, col0 = wc * 32 + 8 * fq; const float* bp = bias + (u.pm >> 5) * 256 + col0;
#pragma unroll
        for (int bj = 0; bj < 2; ++bj) { const f32x4 b0 = *(const f32x4*)(bp + bj * 128), b1 = *(const f32x4*)(bp + bj * 128 + 4);
#pragma unroll
            EPI_LOOP_ROWS { f32x4 v0 = acc[ai][bj][m][0] + b0, v1 = acc[ai][bj][m][1] + b1;
#pragma unroll
                for (int e = 0; e < 4; ++e) { v0[e] = silu_f(v0[e]); v1[e] = silu_f(v1[e]); }
                st8_bf16(O + (size_t)(row0 + ai * 128 + m * 16) * 256 + col0 + bj * 128, v0, v1); } }
    }
};
struct EpiCmp {
    bf16_t* O;
    DI void operator()(const Acc& acc, const Unit& u, int wr, int wc, int fr, int fq) const {
        if (wc >= 2) return;
        const int row0 = u.pm * 256 + wr * 64 + fr, col0 = wc * 32 + 8 * fq;
#pragma unroll
        EPI_LOOP_ROWS { const int row = row0 + ai * 128 + m * 16; f32x4 v0 = acc[ai][0][m][0], v1 = acc[ai][0][m][1];
            if ((row & 127) == 127) { v0 = (f32x4){0.f, 0.f, 0.f, 0.f}; v1 = v0; }
            st8_bf16(O + (size_t)row * 64 + col0, v0, v1); }
    }
};


#define XB_TMO      128
#define XB_XCNT(j)  (256  + 64 * (j))
#define XB_XSUB(j)  (1280 + 64 * (j))
#define XB_XGEN(j)  (2304 + 64 * (j))
#define XB_TOP      3328
#define XB_TOPGEN   3392
#define XCD_BAR_WORDS 3456
#define XB_SPIN_CAP (1u << 22)
DI unsigned xb_ld(unsigned* p)              { return __hip_atomic_load(p, __ATOMIC_RELAXED, __HIP_MEMORY_SCOPE_AGENT); }
DI unsigned xb_add(unsigned* p, unsigned v) { return __hip_atomic_fetch_add(p, v, __ATOMIC_RELAXED, __HIP_MEMORY_SCOPE_AGENT); }
DI unsigned xb_xcc_id() { return (unsigned)__builtin_amdgcn_s_getreg((3 << 11) | 20) & 0xFu; }
#define XB_SPIN(cond, bar) do { unsigned _sp = 0; while (cond) { __builtin_amdgcn_s_sleep(1); \
    if ((++_sp & 255u) == 0u) { if (xb_ld(&(bar)[XB_TMO])) break; if (_sp > XB_SPIN_CAP) { atomicAdd(&(bar)[XB_TMO], 1u); break; } } } } while (0)
struct XcdBarrier { unsigned* bar; unsigned x; volatile LAS unsigned* st; };
DI XcdBarrier xcd_barrier_post(unsigned* bar, volatile LAS unsigned* st) {
    XcdBarrier b; b.bar = bar; b.x = xb_xcc_id(); b.st = st;
    if (threadIdx.x == 0) (void)xb_add(&bar[XB_XCNT(b.x)], 1u);
    return b;
}
DI void xcd_barrier_complete(unsigned* bar, unsigned x, unsigned& nloc, unsigned& nx) {
    const unsigned G = gridDim.x * gridDim.y * gridDim.z;
    unsigned sum, cnt, mine, sp = 0u;
    for (;;) {
        sum = 0u; cnt = 0u; mine = 0u;
#pragma unroll
        for (unsigned j = 0; j < 16; ++j) { const unsigned c = xb_ld(&bar[XB_XCNT(j)]); sum += c; cnt += (c > 0u) ? 1u : 0u; mine = (j == x) ? c : mine; }
        if (sum == G) break;
        __builtin_amdgcn_s_sleep(1);
        if ((++sp & 255u) == 0u) { if (xb_ld(&bar[XB_TMO])) break; if (sp > XB_SPIN_CAP) { atomicAdd(&bar[XB_TMO], 1u); break; } }
    }
    nloc = mine > 0u ? mine : 1u; nx = cnt > 0u ? cnt : 1u;
}
DI void xcd_barrier(const XcdBarrier& b) {
    asm volatile("s_waitcnt vmcnt(0)" ::: "memory");
    __syncthreads();
    if (threadIdx.x == 0) {
        unsigned* bar = b.bar;
        __builtin_amdgcn_s_waitcnt(0);
        unsigned nloc = b.st[0], nx = b.st[1];
        if (nloc == 0u) { xcd_barrier_complete(bar, b.x, nloc, nx); b.st[0] = nloc; b.st[1] = nx; }
        const unsigned old = xb_add(&bar[XB_XSUB(b.x)], 1u);
        const unsigned gen = old / nloc;
        if (old + 1u == (gen + 1u) * nloc) {
            __builtin_amdgcn_fence(__ATOMIC_RELEASE, "agent");
            asm volatile("s_waitcnt vmcnt(0)" ::: "memory");
            const unsigned og = xb_add(&bar[XB_TOP], 1u);
            const unsigned tg = og / nx;
            if (og + 1u == (tg + 1u) * nx) xb_add(&bar[XB_TOPGEN], 1u);
            else XB_SPIN(xb_ld(&bar[XB_TOPGEN]) == tg, bar);
            __builtin_amdgcn_fence(__ATOMIC_ACQUIRE, "agent");
            xb_add(&bar[XB_XGEN(b.x)], 1u);
            asm volatile("s_waitcnt vmcnt(0)" ::: "memory");
        } else {
            XB_SPIN(xb_ld(&bar[XB_XGEN(b.x)]) == gen, bar);
            __builtin_amdgcn_fence(__ATOMIC_ACQUIRE, "agent");
            asm volatile("s_waitcnt vmcnt(0)" ::: "memory");
        }
    }
    __syncthreads();
}

struct Args { const float* in[15]; float* out; unsigned char* ws; int ph_lo, ph_hi; };
enum { I_X = 0, I_LNG, I_LNB, I_PWIN, I_PWGRP, I_PSCALE, I_PWOUT, I_NWIN, I_POSK, I_W1K, I_W2K, I_POSV, I_W1V, I_W2V, I_NWOUT };

DI void transpose_item(const float* W, int ldw, int Nsrc, int Npad, bf16_t* WT, int ldt, LAS float* scr, int item, int lane, const float* rs = nullptr) {
    const int nblk = Npad / 32, kb = item / nblk, nb = item % nblk, k0 = 64 * kb, n0 = 32 * nb;
    const int nn = n0 + (lane & 31); const bool ok = nn < Nsrc;
#pragma unroll 8
    for (int i = 0; i < 32; ++i) { const int kk = 2 * i + (lane >> 5); scr[kk * 33 + (lane & 31)] = ok ? W[(size_t)(k0 + kk) * ldw + nn] * (rs ? rs[k0 + kk] : 1.f) : 0.f; }
    asm volatile("s_waitcnt lgkmcnt(0)" ::: "memory");
    const int c = lane & 7;
#pragma unroll
    for (int j = 0; j < 4; ++j) { const int n = (lane >> 3) + 8 * j; const LAS float* s = scr + (8 * c) * 33 + n;
        u32x4 o; o.x = cvtpk(s[0 * 33], s[1 * 33]); o.y = cvtpk(s[2 * 33], s[3 * 33]); o.z = cvtpk(s[4 * 33], s[5 * 33]); o.w = cvtpk(s[6 * 33], s[7 * 33]);
        *(u32x4*)(WT + (size_t)(n0 + n) * ldt + k0 + 8 * c) = o; }
    asm volatile("s_waitcnt lgkmcnt(0)" ::: "memory");
}

DI void phase_convert(const Args& a, LAS unsigned char* lds, int skip, bool with_wc_ops) {
    unsigned char* ws = a.ws;
    const int tid = threadIdx.x, lane = tid & 63, wave = __builtin_amdgcn_readfirstlane(tid >> 6);
    if ((int)blockIdx.x < skip) return;
    const int G = gridDim.x - skip, gw = ((int)blockIdx.x - skip) * 8 + wave, NGW = G * 8, bidc = (int)blockIdx.x - skip;
    LAS float* scr = (LAS float*)(lds + wave * 16384);
    constexpr int J0 = 16 * 64, J1 = 32 * 32, J2 = 16 * 120, J3 = 32 * 8, J5 = 4 * 8, J7 = 16 * 32, J8 = 8 * 16;
    constexpr int NIT0 = J0 + J1 + J2 + 2 * J3 + 2 * J5 + J7;
    const int NIT = NIT0 + (with_wc_ops ? 4 * J8 : 0);
    for (int it = gw; it < NIT; it += NGW) {
        int r = it;
        if (r < J0) { transpose_item(a.in[I_PWIN] + 2048, 4096, 2048, 2048, (bf16_t*)(ws + WS_WZT), 1024, scr, r, lane); continue; } r -= J0;
        if (r < J1) { transpose_item(a.in[I_PWOUT], 1024, 1024, 1024, (bf16_t*)(ws + WS_WPOT), 2048, scr, r, lane); continue; } r -= J1;
        if (r < J2) { transpose_item(a.in[I_NWIN], NSA_IN, NSA_IN, NSA_PAD, (bf16_t*)(ws + WS_WNIT), 1024, scr, r, lane, a.in[I_LNG]); continue; } r -= J2;
        if (r < J3) { transpose_item(a.in[I_W1K], 256, 256, 256, (bf16_t*)(ws + WS_W1T), 2048, scr, r, lane); continue; } r -= J3;
        if (r < J3) { transpose_item(a.in[I_W1V], 256, 256, 256, (bf16_t*)(ws + WS_W1T) + 256 * 2048, 2048, scr, r, lane); continue; } r -= J3;
        if (r < J5) { transpose_item(a.in[I_W2K], 64, 64, 256, (bf16_t*)(ws + WS_W2T), 256, scr, r, lane); continue; } r -= J5;
        if (r < J5) { transpose_item(a.in[I_W2V], 64, 64, 256, (bf16_t*)(ws + WS_W2T) + 256 * 256, 256, scr, r, lane); continue; } r -= J5;
        if (r < J7) { transpose_item(a.in[I_NWOUT], 1024, 1024, 1024, (bf16_t*)(ws + WS_WNOT), 1024, scr, r, lane); continue; } r -= J7;
        { const int g = r / J8; r -= g * J8; transpose_item(a.in[I_PWGRP] + (size_t)g * 512 * 512, 512, 512, 512, (bf16_t*)(ws + WS_WGT) + (size_t)g * 512 * 512, 512, scr, r, lane); }
    }
    { const float* W = a.in[I_PWIN]; bf16_t* O = (bf16_t*)(ws + WS_WINB);
      if (with_wc_ops) for (int e = bidc * 512 + tid; e < 1024 * 512; e += G * 512) { const int k = e >> 9, c4 = (e & 511) * 4; const f32x4 v = *(const f32x4*)(W + (size_t)k * 4096 + c4);
          u32x2 o; o.x = cvtpk(v[0], v[1]); o.y = cvtpk(v[2], v[3]); *(u32x2*)(O + (size_t)k * 2048 + c4) = o; } }
    for (int wi = gw; wi < (NSA_PAD / 64) * 32; wi += NGW) {
        const int chunk = wi % (NSA_PAD / 64), ks = wi / (NSA_PAD / 64), c = chunk * 64 + lane;
        const float* W = a.in[I_NWIN]; const float* gam = a.in[I_LNG]; const float* bet = a.in[I_LNB];
        float sg = 0.f, sb = 0.f;
        if (c < NSA_IN) {
#pragma unroll
            for (int j = 0; j < 32; ++j) { const int k = ks * 32 + j; const float wv = W[(size_t)k * NSA_IN + c]; sg += gam[k] * wv; sb += bet[k] * wv; } }
        float* part = (float*)(ws + WS_PART); part[(size_t)(ks * 2) * NSA_PAD + c] = sg; part[(size_t)(ks * 2 + 1) * NSA_PAD + c] = sb;
    }
    for (int wi = gw; wi < 64; wi += NGW) {
        const int kv = wi >> 5, n0 = (wi & 31) * 8, kk = lane >> 3, nn = lane & 7;
        const float* pos = a.in[kv ? I_POSV : I_POSK]; const float* w1 = a.in[kv ? I_W1V : I_W1K];
        float s = 0.f;
        for (int j = 0; j < 256; ++j) { const int k = kk + 8 * j; s += pos[k] * w1[(size_t)k * 256 + n0 + nn]; }
        s += __shfl_xor(s, 8); s += __shfl_xor(s, 16); s += __shfl_xor(s, 32);
        if (lane < 8) ((float*)(ws + WS_BIAS))[kv * 256 + n0 + nn] = s;
    }
}

struct SchedOne { const char* A; const char* B; int pm, pn; DI bool next(int i, Unit& u) const { if (i) return false; u.pm = pm; u.pn = pn; u.a = A; u.b = B; return true; } };
DI void wc_unit(const Args& a, LAS unsigned char* lds, int unit) {
    const int tid = threadIdx.x, lane = tid & 63, wave = __builtin_amdgcn_readfirstlane(tid >> 6);
    const int pm = unit >> 2, pn = unit & 3, g = pm >> 1, d0 = (pm & 1) * 256, k0 = pn * 256;
    bf16_t* Ap = (bf16_t*)(a.ws + WS_A) + (size_t)unit * (2 * 256 * 512);
    bf16_t* Bp = Ap + 256 * 512;
    LAS float* scr = (LAS float*)(lds + wave * 16384);
    for (int it = wave; it < 8 * 8; it += 8) transpose_item(a.in[I_PWGRP] + (size_t)g * 512 * 512 + d0, 512, 256, 256, Ap, 512, scr, it, lane);
    { const float* W = a.in[I_PWIN] + (size_t)k0 * 4096 + g * 512;
      for (int e = tid; e < 256 * 128; e += 512) { const int k = e >> 7, c4 = (e & 127) * 4; const f32x4 v = *(const f32x4*)(W + (size_t)k * 4096 + c4);
          u32x2 o; o.x = cvtpk(v[0], v[1]); o.y = cvtpk(v[2], v[3]); *(u32x2*)(Bp + (size_t)k * 512 + c4) = o; } }
    asm volatile("s_waitcnt vmcnt(0) lgkmcnt(0)" ::: "memory"); __syncthreads();
    const pg8::Geom gm{512, 512, 512, 128, 128, 128 * 512 * 2, 128 * 512 * 2};
    SchedOne S{(const char*)Ap, (const char*)Bp, pm, pn};
    EpiWc E{(bf16_t*)(a.ws + WS_WCT), a.in[I_PSCALE]};
    pg8::gemm_phase<EpiWc, SchedOne, false>(lds, gm, S, E);
}

#define POOL_LOAD(ARR, ROW0, GUARD) _Pragma("unroll") for (int j_ = 0; j_ < 8; ++j_) { ARR[j_] = (GUARD) ? __builtin_nontemporal_load((const f32x4*)(xp + (ptrdiff_t)((ROW0) + j_) * DM)) : (f32x4){0.f, 0.f, 0.f, 0.f}; }
#define POOL_INV(W, TL) ((edge_ && (TL) + 1 < (W)) ? 1.f / (float)((TL) + 1) : 1.f / (float)(W))
#define POOL_ST(PTR, V) { const f32x4 m_ = (V); u32x2 o_; o_.x = cvtpk(m_[0], m_[1]); o_.y = cvtpk(m_[2], m_[3]); __builtin_nontemporal_store(o_, (u32x2*)(PTR)); }
#define POOL_PROC(H0, H1, C, ROW0) { \
    _Pragma("unroll") for (int j_ = 0; j_ < 8; ++j_) { \
        const f32x4 x_ = C[j_]; const f32x4 p1_ = j_ >= 1 ? C[j_ >= 1 ? j_ - 1 : 0] : H1[7]; \
        const f32x4 W2 = p1_ + x_, W4 = S4 + x_, W8 = S8 + x_, W16 = S16 + x_; \
        const int tl_ = (ROW0) + j_; const size_t off_ = (size_t)(t0 + tl_) * DM + c4; \
        POOL_ST(XB + off_, x_) \
        POOL_ST(XP + off_, W2 * POOL_INV(2, tl_) - x_) \
        POOL_ST(XP + (size_t)MTOK * DM + off_, W4 * POOL_INV(4, tl_) - x_) \
        POOL_ST(XP + (size_t)2 * MTOK * DM + off_, W8 * POOL_INV(8, tl_) - x_) \
        POOL_ST(XP + (size_t)3 * MTOK * DM + off_, W16 * POOL_INV(16, tl_) - x_) \
        S4 = W4 - (j_ >= 3 ? C[j_ >= 3 ? j_ - 3 : 0] : H1[j_ < 3 ? j_ + 5 : 0]); S8 = W8 - (j_ >= 7 ? C[0] : H1[j_ < 7 ? j_ + 1 : 0]); S16 = W16 - (j_ >= 7 ? H1[0] : H0[j_ < 7 ? j_ + 1 : 0]); } }
DI void phase_pool(const Args& a, int blk, int nblk) {
    const float* X = a.in[I_X]; bf16_t* XB = (bf16_t*)(a.ws + WS_XB); bf16_t* XP = (bf16_t*)(a.ws + WS_XP);
    const int nitems = (MTOK / 64) * 256;
    for (int it = blk * 512 + (int)threadIdx.x; it < nitems; it += nblk * 512) {
        const int chunk = it >> 8, c4 = (it & 255) * 4, t0 = chunk * 64, tl0 = t0 & (SEQ - 1);
        const bool edge_ = tl0 == 0;
        const float* xp = X + (size_t)t0 * DM + c4;
        f32x4 A[8], B[8], C[8], D[8];
        POOL_LOAD(A, -16, !edge_)
        POOL_LOAD(B, -8, !edge_)
        POOL_LOAD(C, 0, true)
        POOL_LOAD(D, 8, true)
        f32x4 S16 = A[1], S8 = B[1], S4 = B[5] + B[6] + B[7];
#pragma unroll
        for (int j = 2; j < 8; ++j) { S16 = S16 + A[j]; S8 = S8 + B[j]; }
        S16 = S16 + B[0] + S8;
        POOL_PROC(A, B, C, 0)  POOL_LOAD(A, 16, true)
        POOL_PROC(B, C, D, 8)  POOL_LOAD(B, 24, true)
        POOL_PROC(C, D, A, 16) POOL_LOAD(C, 32, true)
        POOL_PROC(D, A, B, 24) POOL_LOAD(D, 40, true)
        POOL_PROC(A, B, C, 32) POOL_LOAD(A, 48, true)
        POOL_PROC(B, C, D, 40) POOL_LOAD(B, 56, true)
        POOL_PROC(C, D, A, 48)
        POOL_PROC(D, A, B, 56)
    }
}
#undef POOL_LOAD
#undef POOL_INV
#undef POOL_ST
#undef POOL_PROC

DI void phase_ln(const float* V, float* O, bf16_t* OB, const float* gam, const float* bet) {
    const int lane = threadIdx.x & 63, wave = threadIdx.x >> 6; const int gw = blockIdx.x * 8 + wave, NGW = gridDim.x * 8;
    f32x4 gg[4], bb[4];
#pragma unroll
    for (int j = 0; j < 4; ++j) { gg[j] = *(const f32x4*)(gam + 4 * lane + 256 * j); bb[j] = *(const f32x4*)(bet + 4 * lane + 256 * j); }
    for (int m = gw; m < MTOK; m += NGW) {
        const float* vr = V + (size_t)m * DM + 4 * lane; f32x4 v[4]; float s = 0.f;
#pragma unroll
        for (int j = 0; j < 4; ++j) { v[j] = *(const f32x4*)(vr + 256 * j); s += (v[j][0] + v[j][1]) + (v[j][2] + v[j][3]); }
        const float mean = wave_sum(s) * (1.f / DM); float s2 = 0.f;
#pragma unroll
        for (int j = 0; j < 4; ++j) { v[j] = v[j] - mean; s2 += (v[j][0] * v[j][0] + v[j][1] * v[j][1]) + (v[j][2] * v[j][2] + v[j][3] * v[j][3]); }
        const float rstd = 1.f / sqrtf(wave_sum(s2) * (1.f / DM) + LN_EPS);
#pragma unroll
        for (int j = 0; j < 4; ++j) { const f32x4 y = v[j] * rstd * gg[j] + bb[j]; *(f32x4*)(O + (size_t)m * DM + 4 * lane + 256 * j) = y;
            if (OB) { u32x2 o; o.x = cvtpk(y[0], y[1]); o.y = cvtpk(y[2], y[3]); *(u32x2*)(OB + (size_t)m * DM + 4 * lane + 256 * j) = o; } }
    }
}

DI void phase_final(const float* V, const float* SF, const bf16_t* Y1, float* O, const float* gam, const float* bet) {
    const int lane = threadIdx.x & 63, wave = threadIdx.x >> 6; const int gw = blockIdx.x * 8 + wave, NGW = gridDim.x * 8;
    f32x4 g0[4], b0[4], g1[4], b1[4];
#pragma unroll
    for (int j = 0; j < 4; ++j) { const int c = 4 * lane + 256 * j; g0[j] = *(const f32x4*)(gam + c); b0[j] = *(const f32x4*)(bet + c); g1[j] = *(const f32x4*)(gam + DM + c); b1[j] = *(const f32x4*)(bet + DM + c); }
    for (int m = gw; m < MTOK; m += NGW) {
        float mean0, rstd0; row_stats(SF, m, mean0, rstd0);
        f32x4 v[4]; float s = 0.f;
#pragma unroll
        for (int j = 0; j < 4; ++j) { const size_t off = (size_t)m * DM + 4 * lane + 256 * j; const f32x4 t = __builtin_nontemporal_load((const f32x4*)(V + off)); const u32x2 y = __builtin_nontemporal_load((const u32x2*)(Y1 + off));
            const f32x4 x1 = (t - mean0) * rstd0 * g0[j] + b0[j]; const f32x4 yv = {bf_lo(y.x), bf_hi(y.x), bf_lo(y.y), bf_hi(y.y)};
            v[j] = x1 * DN_ALPHA + yv; s += (v[j][0] + v[j][1]) + (v[j][2] + v[j][3]); }
        const float mean = wave_sum(s) * (1.f / DM); float s2 = 0.f;
#pragma unroll
        for (int j = 0; j < 4; ++j) { v[j] = v[j] - mean; s2 += (v[j][0] * v[j][0] + v[j][1] * v[j][1]) + (v[j][2] * v[j][2] + v[j][3] * v[j][3]); }
        const float rstd = 1.f / sqrtf(wave_sum(s2) * (1.f / DM) + LN_EPS);
#pragma unroll
        for (int j = 0; j < 4; ++j) __builtin_nontemporal_store(v[j] * rstd * g1[j] + b1[j], (f32x4*)(O + (size_t)m * DM + 4 * lane + 256 * j));
    }
}

constexpr int A_KT = 0, A_KT_SZ = 8192;
constexpr int A_VT = 3 * A_KT_SZ, A_VT_SZ = 8192;
constexpr int A_KC = A_VT + 3 * A_VT_SZ;
constexpr int A_VC = A_KC + 16384;
constexpr int A_IMP = 86016;
constexpr int A_TOT = A_IMP + 4 * 64 * 33 * 4;
constexpr int A_SEL = A_TOT + 8192;
constexpr int A_GATE = 132096;
static_assert(A_VC + 16384 <= A_IMP && A_SEL + 512 <= 131072 && A_GATE + 4096 <= 147456, "attention LDS map");
typedef short v4i16_t __attribute__((ext_vector_type(4)));
constexpr int NEGBITS = (int)0xF149F2CAu;
DI int crow(int i, int h) { return (i & 3) + 8 * (i >> 2) + 4 * h; }
DI bf16x8 pack8(const f32x16& x, int s) { u32x4 p; p.x = cvtpk(x[8 * s], x[8 * s + 1]); p.y = cvtpk(x[8 * s + 2], x[8 * s + 3]); p.z = cvtpk(x[8 * s + 4], x[8 * s + 5]); p.w = cvtpk(x[8 * s + 6], x[8 * s + 7]); return __builtin_bit_cast(bf16x8, p); }

DI void qk_tile(const LAS unsigned char* kb_, const bf16x8 (&qf)[4], const f32x16& AK, f32x16 (&S)[2], int r, int h) {
    const int kx = (r >> 1) & 7;
#pragma unroll
    for (int kb = 0; kb < 2; ++kb) {
#pragma unroll
        for (int s = 0; s < 4; ++s) { const bf16x8 kf = *(const LAS bf16x8*)(kb_ + (kb * 32 + r) * 128 + (((2 * s + h) ^ kx) << 4)); S[kb] = MFMA32(kf, qf[s], s == 0 ? AK : S[kb]); }
    }
}
DI void sm_pv_tile(f32x16 (&S)[2], const LAS unsigned char* vb_, f32x16 (&O)[2], float& mrun, float& lrun,
                   int kind, int n, int i, int tq, int qv, float slope2, unsigned selm, const int (&voff)[2][2],
                   bool do_qk, const LAS unsigned char* kn_, const bf16x8 (&qf)[4], const f32x16& AK, f32x16 (&SN)[2], int r, int h) {
    if (n == i || (kind == 0 && n == i - 4)) {
        const int flip = (n == i) ? 0 : -1;
#pragma unroll
        for (int kb = 0; kb < 2; ++kb)
#pragma unroll
            for (int e = 0; e < 16; ++e) { const int v = qv - (32 * kb + crow(e, 0)); S[kb][e] += __builtin_bit_cast(float, ((v ^ flip) >> 31) & NEGBITS); }
    }
    float mx0 = S[0][0], mx1 = S[1][0];
#pragma unroll
    for (int e = 1; e < 16; ++e) { mx0 = fmaxf(mx0, S[0][e]); mx1 = fmaxf(mx1, S[1][e]); }
    const float c32 = 32.f * slope2;
    float mx = fmaxf(mx0, mx1 + c32);
    mx = fmaxf(mx, __shfl_xor(mx, 32));
    const float ct = slope2 * (float)(tq - 64 * n);
    const bool qsel = kind ? ((selm >> n) & 1u) != 0u : true;
    const float mxt = qsel ? mx - ct : -1e30f;
    const bool need = mxt > mrun + 8.f;
    if (__ballot(need) != 0ull) {
        const float mnew = need ? mxt : mrun, alpha = fexp2(mrun - mnew); mrun = mnew; lrun *= alpha;
        O[0] = O[0] * alpha; O[1] = O[1] * alpha;
    }
    const float off = qsel ? mrun + ct : 1e30f;
    __builtin_amdgcn_s_setprio(1); qk_tile(kn_, qf, AK, SN, r, h); __builtin_amdgcn_s_setprio(0);
    float ls = 0.f;
#pragma unroll
    for (int kb = 0; kb < 2; ++kb)
#pragma unroll
        for (int e = 0; e < 16; ++e) { const float p = fexp2(S[kb][e] - (kb ? off - c32 : off)); S[kb][e] = p; ls += p; }
    lrun += ls;
    __builtin_amdgcn_s_setprio(1);
#pragma unroll
    for (int kb = 0; kb < 2; ++kb)
#pragma unroll
        for (int s2 = 0; s2 < 2; ++s2) { const bf16x8 pb = pack8(S[kb], s2);
#pragma unroll
            for (int dt = 0; dt < 2; ++dt) { const LAS unsigned char* vp = vb_ + (32 * kb + 16 * s2) * 128;
                const s16x4 lo = __builtin_bit_cast(s16x4, __builtin_amdgcn_ds_read_tr16_b64_v4i16((LAS v4i16_t*)(vp + voff[dt][0])));
                const s16x4 hi = __builtin_bit_cast(s16x4, __builtin_amdgcn_ds_read_tr16_b64_v4i16((LAS v4i16_t*)(vp + voff[dt][1])));
                const bf16x8 vf = __builtin_shufflevector(lo, hi, 0, 1, 2, 3, 4, 5, 6, 7); O[dt] = MFMA32(vf, pb, O[dt]); } }
    __builtin_amdgcn_s_setprio(0);
}
DI void tile_dma2(LAS unsigned char* dstK, LAS unsigned char* dstV, const bf16_t* Ksrc, const bf16_t* Vsrc, size_t base, int pitch, int w, int lane) {
    const int row = w * 8 + (lane >> 3), c = (lane & 7) ^ ((row >> 1) & 7);
    const size_t goff = base + (size_t)row * pitch + c * 8;
    __builtin_amdgcn_global_load_lds((const unsigned*)(Ksrc + goff), (LAS unsigned*)(dstK + w * 1024), 16, 0, 0);
    __builtin_amdgcn_global_load_lds((const unsigned*)(Vsrc + goff), (LAS unsigned*)(dstV + w * 1024), 16, 0, 0);
}
DI void cmp_dma(LAS unsigned char* lds, const bf16_t* CMP, int b, int g, int w, int lane) {
    const size_t base = (size_t)((b * 4 + g) * 128) * 64; const bf16_t* vc = CMP + (size_t)8192 * 64;
    tile_dma2(lds + A_KC, lds + A_VC, CMP, vc, base, 64, w, lane);
    tile_dma2(lds + A_KC + 8192, lds + A_VC + 8192, CMP, vc, base + 64 * 64, 64, w, lane);
}
DI void tile_dma(LAS unsigned char* lds, int bufi, const bf16_t* Ksrc, const bf16_t* Vsrc, size_t base, int w, int lane) {
    const int row = w * 8 + (lane >> 3), c = (lane & 7) ^ ((row >> 1) & 7);
    const size_t goff = base + (size_t)row * 256 + c * 8;
    __builtin_amdgcn_global_load_lds((const unsigned*)(Ksrc + goff), (LAS unsigned*)(lds + A_KT + bufi * A_KT_SZ + w * 1024), 16, 0, 0);
    __builtin_amdgcn_global_load_lds((const unsigned*)(Vsrc + goff), (LAS unsigned*)(lds + A_VT + bufi * A_VT_SZ + w * 1024), 16, 0, 0);
}

DI void attn_item(LAS unsigned char* lds, const bf16_t* QB, const bf16_t* KV, const bf16_t* CMP, const bf16_t* SZN, const float* GT, bf16_t* AO, int b, int i, int g, bool first, bool has_nx, int nxb, int nxg) {
    int tid_ = threadIdx.x; asm volatile("" : "+v"(tid_));
    const int tid = tid_, lane = tid & 63, w = __builtin_amdgcn_readfirstlane(tid >> 6), hh = w >> 1, qh = w & 1, r = lane & 31, h = lane >> 5;
    const int ql = 32 * qh + r, tq = 64 * i + ql, head = 4 * g + hh;
    const size_t row = (size_t)b * SEQ + tq;
    const bf16_t* KS = KV + (size_t)2 * MTOK * 256; const bf16_t* VS = KV + (size_t)3 * MTOK * 256;
    const bf16_t* KW = KV + (size_t)4 * MTOK * 256; const bf16_t* VW = KV + (size_t)5 * MTOK * 256;
    if (first) cmp_dma(lds, CMP, b, g, w, lane);
    if (tid == 0) ((LAS unsigned*)(lds + A_SEL))[64] = 0u;
    int voff[2][2];
    { const int q_ = (lane & 15) >> 2, p_ = lane & 3, blk_ = (lane >> 4) & 1, x_ = 2 * h + (q_ >> 1);
#pragma unroll
      for (int dt = 0; dt < 2; ++dt)
#pragma unroll
          for (int hi = 0; hi < 2; ++hi) voff[dt][hi] = (4 * h + q_ + 8 * hi) * 128 + (((4 * dt + 2 * blk_ + (p_ >> 1)) ^ (x_ ^ (4 * hi))) << 4) + (p_ & 1) * 8; }
    bf16x8 qf[4];
    { const bf16_t* qp = QB + row * 1024 + head * 64 + 8 * h;
#pragma unroll
      for (int s = 0; s < 4; ++s) qf[s] = *(const bf16x8*)(qp + 16 * s); }
    const float* gp = GT + row * 48 + head * 3; const float g0 = gp[0];
    { f32x2 g12 = {gp[1], gp[2]}; *(LAS f32x2*)(lds + A_GATE + tid * 8) = g12; }
    const float slope2 = fexp2(-0.5f * (float)(head + 1)) * LOG2E;
    __syncthreads();
    const size_t tbase = ((size_t)b * SEQ) * 256 + g * 64;
    tile_dma(lds, 0, KW, VW, tbase + (size_t)(64 * i) * 256, w, lane);
    if (i > 0) tile_dma(lds, 1, KW, VW, tbase + (size_t)(64 * (i - 1)) * 256, w, lane); else tile_dma(lds, 1, KS, VS, tbase, w, lane);
    f32x16 Oacc[2];
    {
        const int nkb = (i >> 3) + 1;
        f32x16 S[4];
        float mx = -1e30f;
#pragma unroll
        for (int kb = 0; kb < 4; ++kb) {
#pragma unroll
            for (int e = 0; e < 16; ++e) S[kb][e] = 0.f;
            if (kb < nkb) {
#pragma unroll
                for (int s = 0; s < 4; ++s) { const bf16x8 kf = *(const LAS bf16x8*)(lds + A_KC + (kb >> 1) * 8192 + ((kb & 1) * 32 + r) * 128 + (((2 * s + h) ^ ((r >> 1) & 7)) << 4)); S[kb] = MFMA32(kf, qf[s], S[kb]); }
#pragma unroll
                for (int e = 0; e < 16; ++e) { const int c = 32 * kb + crow(e, h); const int dist = tq - (16 * c + 31); const float sv = S[kb][e] - slope2 * (float)dist;
                    S[kb][e] = sv + __builtin_bit_cast(float, (dist >> 31) & NEGBITS); mx = fmaxf(mx, S[kb][e]); }
            }
        }
        mx = fmaxf(fmaxf(mx, __shfl_xor(mx, 32)), -1e20f);
        float l = 0.f;
#pragma unroll
        for (int kb = 0; kb < 4; ++kb) if (kb < nkb) {
#pragma unroll
            for (int e = 0; e < 16; ++e) { const float p = fexp2(S[kb][e] - mx); S[kb][e] = p; l += p; } }
        l += __shfl_xor(l, 32);
        const float inv = l > 0.f ? 1.f / l : 0.f;
        LAS float* imp = (LAS float*)(lds + A_IMP) + (hh * 64 + ql) * 33;
        float carry = 0.f;
#pragma unroll
        for (int kb = 0; kb < 4; ++kb) {
            if (kb < nkb) { S[kb] = S[kb] * inv;
#pragma unroll
                for (int ig = 0; ig < 4; ++ig) { const float gsum = (S[kb][4 * ig] + S[kb][4 * ig + 1]) + (S[kb][4 * ig + 2] + S[kb][4 * ig + 3]); const float plv = __shfl_xor(S[kb][4 * ig + 3], 32);
                    imp[8 * kb + 2 * ig + h] = gsum + (h ? plv : carry); carry = plv; } }
            else {
#pragma unroll
                for (int ig = 0; ig < 4; ++ig) { imp[8 * kb + 2 * ig + h] = (h == 0 && ig == 0) ? carry : 0.f; if (ig == 0) carry = 0.f; } } }
        f32x16 O[2];
#pragma unroll
        for (int dt = 0; dt < 2; ++dt)
#pragma unroll
            for (int e = 0; e < 16; ++e) O[dt][e] = 0.f;
#pragma unroll
        for (int kb = 0; kb < 4; ++kb) if (kb < nkb) {
#pragma unroll
            for (int s2 = 0; s2 < 2; ++s2) { const bf16x8 pb = pack8(S[kb], s2);
#pragma unroll
                for (int dt = 0; dt < 2; ++dt) { const LAS unsigned char* vp = lds + A_VC + (kb >> 1) * 8192 + ((kb & 1) * 32 + 16 * s2) * 128;
                    const s16x4 lo = __builtin_bit_cast(s16x4, __builtin_amdgcn_ds_read_tr16_b64_v4i16((LAS v4i16_t*)(vp + voff[dt][0])));
                    const s16x4 hi = __builtin_bit_cast(s16x4, __builtin_amdgcn_ds_read_tr16_b64_v4i16((LAS v4i16_t*)(vp + voff[dt][1])));
                    const bf16x8 vf = __builtin_shufflevector(lo, hi, 0, 1, 2, 3, 4, 5, 6, 7); O[dt] = MFMA32(vf, pb, O[dt]); } } }
        Oacc[0] = O[0] * g0; Oacc[1] = O[1] * g0;
    }
#define LBAR() do { asm volatile("s_waitcnt lgkmcnt(0)" ::: "memory"); __builtin_amdgcn_s_barrier(); } while (0)
    LBAR();
    if (has_nx) cmp_dma(lds, CMP, nxb, nxg, w, lane);
    {
        LAS float* IMP = (LAS float*)(lds + A_IMP); LAS float* TOT = (LAS float*)(lds + A_TOT); LAS unsigned* SEL = (LAS unsigned*)(lds + A_SEL);
        const int n = tid & 31;
#pragma unroll
        for (int ps = 0; ps < 4; ++ps) { const int q = ps * 16 + (tid >> 5);
            float v = (IMP[(0 * 64 + q) * 33 + n] + IMP[(1 * 64 + q) * 33 + n]) + (IMP[(2 * 64 + q) * 33 + n] + IMP[(3 * 64 + q) * 33 + n]);
            if (n == 0 || n == i || n == i - 1) v = 1e9f; else if (n > i) v = -1e30f;
            TOT[q * 32 + n] = v; }
        LBAR();
        unsigned uni = 0u;
#pragma unroll
        for (int ps = 0; ps < 4; ++ps) { const int q = ps * 16 + (tid >> 5); const float my = TOT[q * 32 + n]; int rank = 0;
#pragma unroll
            for (int j = 0; j < 8; ++j) { if (4 * j > i) break;
                const f32x4 t4 = *(const LAS f32x4*)(TOT + q * 32 + 4 * j);
#pragma unroll
                for (int e = 0; e < 4; ++e) { const int n2 = 4 * j + e; rank += (t4[e] > my || (t4[e] == my && n2 < n)) ? 1 : 0; } }
            const unsigned long long bal = __ballot(rank < 8);
            const unsigned lo = (unsigned)bal, hi = (unsigned)(bal >> 32);
            if (lane == 0) SEL[q] = lo; if (lane == 32) SEL[q] = hi;
            uni |= lo | hi; }
        const unsigned allowed = (i >= 31) ? 0xffffffffu : ((2u << i) - 1u);
        if (lane == 0) atomicOr((unsigned*)(SEL + 64), uni & allowed);
        LBAR();
    }
#undef LBAR
    const unsigned uni = __builtin_amdgcn_readfirstlane(((LAS unsigned*)(lds + A_SEL))[64]);
    const unsigned selm = ((LAS unsigned*)(lds + A_SEL))[ql];
    f32x16 AK;
#pragma unroll
    for (int e = 0; e < 16; ++e) AK[e] = slope2 * (float)crow(e, h);
    const int nlo = i - 4 < 0 ? 0 : i - 4;
    float mrun = -1e20f, lrun = 0.f; f32x16 O[2];
#pragma unroll
    for (int dt = 0; dt < 2; ++dt)
#pragma unroll
        for (int e = 0; e < 16; ++e) O[dt][e] = 0.f;
    const int qv = ql - 4 * h;
    int ck = 0, cn = i;
    int k1, n1; bool ok1 = true;
    if (cn > nlo) { k1 = 0; n1 = cn - 1; } else { k1 = 1; n1 = 31 - __builtin_clz(uni); }
    int k2 = k1, n2 = 0; bool ok2 = true;
#define TS_ADV(kk, nn, okk, ko, no, oko) do { ko = kk; no = 0; oko = okk; if (okk) { if (kk == 0) { if (nn > nlo) no = nn - 1; else { ko = 1; no = 31 - __builtin_clz(uni); } } \
        else { const unsigned rem_ = uni & ((1u << nn) - 1u); if (rem_ == 0u) oko = false; else no = 31 - __builtin_clz(rem_); } } } while (0)
    TS_ADV(k1, n1, ok1, k2, n2, ok2);
    int bc = 0;
    f32x16 Sa[2], Sb[2];
    asm volatile("s_waitcnt vmcnt(0)" ::: "memory"); __builtin_amdgcn_s_barrier();
    qk_tile(lds + A_KT, qf, AK, Sa, r, h);
#define TILE_STEP(SC, SN) { \
        asm volatile("s_waitcnt vmcnt(0)" ::: "memory");        \
        __builtin_amdgcn_s_barrier();                             \
        { const bool pf_ = ok1 && ok2; const int pk_ = pf_ ? k2 : ck, pn_ = pf_ ? n2 : cn; \
          int b2 = bc + 2; b2 = b2 >= 3 ? b2 - 3 : b2; \
          tile_dma(lds, b2, pk_ ? KS : KW, pk_ ? VS : VW, tbase + (size_t)(64 * pn_) * 256, w, lane); } \
        { const int b1 = bc + 1 >= 3 ? 0 : bc + 1; \
          sm_pv_tile(SC, lds + A_VT + bc * A_VT_SZ, O, mrun, lrun, ck, cn, i, tq, qv, slope2, selm, voff, ok1, lds + A_KT + b1 * A_KT_SZ, qf, AK, SN, r, h); } \
        if (!ok1 || k1 != ck) {       \
            const float lt = lrun + __shfl_xor(lrun, 32); const float sc = *(const LAS float*)(lds + A_GATE + tid * 8 + (ck ? 0 : 4)) * (lt > 0.f ? 1.f / lt : 0.f); \
            Oacc[0] = Oacc[0] + O[0] * sc; Oacc[1] = Oacc[1] + O[1] * sc; \
            mrun = -1e20f; lrun = 0.f; \
            _Pragma("unroll") for (int dt = 0; dt < 2; ++dt) _Pragma("unroll") for (int e = 0; e < 16; ++e) O[dt][e] = 0.f; \
        } \
        if (!ok1) break; \
        ck = k1; cn = n1; k1 = k2; n1 = n2; ok1 = ok2; { int k3, n3; bool ok3; TS_ADV(k2, n2, ok2, k3, n3, ok3); k2 = k3; n2 = n3; ok2 = ok3; } \
        bc = bc + 1 >= 3 ? 0 : bc + 1; }
    for (;;) {
        TILE_STEP(Sa, Sb)
        TILE_STEP(Sb, Sa)
    }
#undef TILE_STEP
#undef TS_ADV
    asm volatile("s_waitcnt vmcnt(0)" ::: "memory");
    __builtin_amdgcn_s_barrier();
    {
        LAS unsigned char* st = lds + (w < 5 ? w * 8704 : A_IMP + (w - 5) * 8704);
#pragma unroll
        for (int dt = 0; dt < 2; ++dt)
#pragma unroll
            for (int ig = 0; ig < 4; ++ig) { f32x4 v = {Oacc[dt][4 * ig], Oacc[dt][4 * ig + 1], Oacc[dt][4 * ig + 2], Oacc[dt][4 * ig + 3]};
                *(LAS f32x4*)(st + r * 272 + (32 * dt + 8 * ig + 4 * h) * 4) = v; }
        asm volatile("s_waitcnt lgkmcnt(0)" ::: "memory");
        const int qq = lane >> 3, dc = lane & 7;
#pragma unroll
        for (int j = 0; j < 4; ++j) { const int qr = 8 * j + qq;
            const size_t off = ((size_t)b * SEQ + 64 * i + 32 * qh + qr) * 1024 + head * 64 + dc * 8;
            const u32x4 z = *(const u32x4*)(SZN + off);
            const f32x4 o0 = *(const LAS f32x4*)(st + qr * 272 + dc * 32), o1 = *(const LAS f32x4*)(st + qr * 272 + dc * 32 + 16);
            u32x4 o; o.x = cvtpk(o0[0] * bf_lo(z.x), o0[1] * bf_hi(z.x)); o.y = cvtpk(o0[2] * bf_lo(z.y), o0[3] * bf_hi(z.y));
            o.z = cvtpk(o1[0] * bf_lo(z.z), o1[1] * bf_hi(z.z)); o.w = cvtpk(o1[2] * bf_lo(z.w), o1[3] * bf_hi(z.w));
            *(u32x4*)(AO + off) = o; }
    }
}

DI void phase_attn(const Args& a, LAS unsigned char* lds) {
    unsigned char* ws = a.ws; const int G = gridDim.x;
    const bf16_t* QB = (const bf16_t*)(ws + WS_QB); const bf16_t* KV = (const bf16_t*)(ws + WS_KV); const bf16_t* CMP = (const bf16_t*)(ws + WS_CMP);
    const bf16_t* SZN = (const bf16_t*)(ws + WS_SZN); const float* GT = (const float*)(ws + WS_GATE); bf16_t* AO = (bf16_t*)(ws + WS_XB);
    for (int k = 0;; ++k) {
        const long idx = (long)k * G + blockIdx.x; if (idx >= 2048) break;
        const int grp = (int)(idx >> 6), sub = (int)(idx & 63);
        const int per = G >> 6;
        int lvl = grp;
        if (per > 1 && (k & 1)) { const int base = (grp / per) * per; lvl = base + (per - 1 - (grp - base)); if (lvl > 31) lvl = grp; }
        const int i = 31 - lvl, b = sub >> 2, g = (sub + k) & 3;
        const long idx2 = (long)(k + 1) * G + blockIdx.x; const bool has_nx = idx2 < 2048; const int sub2 = (int)(idx2 & 63);
        attn_item(lds, QB, KV, CMP, SZN, GT, AO, b, i, g, k == 0, has_nx, sub2 >> 2, (sub2 + k + 1) & 3);
    }
}

constexpr int LDS_BYTES = 147456, LDS_CTL = 131072;
constexpr int N_PHASES = 12;
__global__ void __launch_bounds__(512, 2) fwd_kernel(Args a) {
    extern __shared__ __attribute__((aligned(16))) unsigned char lds_raw[];
    LAS unsigned char* lds = (LAS unsigned char*)lds_raw;
    unsigned char* ws = a.ws; const int G = gridDim.x, bid = blockIdx.x;
    const int lo = a.ph_lo, hi = a.ph_hi;
#define IN(k) (lo <= (k) && (k) < hi)
    if (threadIdx.x < 8) ((LAS unsigned*)(lds + LDS_CTL))[threadIdx.x] = 0u;
    __syncthreads();
    XcdBarrier bar = xcd_barrier_post((unsigned*)(ws + WS_CTL), (volatile LAS unsigned*)(lds + LDS_CTL));
#define SEAM(k) do { if (IN(k) && IN((k) + 1)) { if ((k) == 0) cg::this_grid().sync(); else xcd_barrier(bar); } } while (0)
    const char* XB = (const char*)(ws + WS_XB);
    const bool wc_private = G >= 64;
    if (IN(0)) {
        if (wc_private) { if (bid < 32) wc_unit(a, lds, bid); phase_convert(a, lds, 32, false); }
        else phase_convert(a, lds, 0, true);
        phase_pool(a, bid, G);
    }
    SEAM(0);
    if (IN(1) && !wc_private) {
        const pg8::Geom g{512, 512, 2048, 128, 128, 128 * 512 * 2, 128 * 2048 * 2};
        SchedWc S{G, bid, (const char*)(ws + WS_WGT), (const char*)(ws + WS_WINB)};
        EpiWc E{(bf16_t*)(ws + WS_WCT), a.in[I_PSCALE]};
        pg8::gemm_phase<EpiWc, SchedWc, false>(lds, g, S, E);
    }
    if (!wc_private) SEAM(1);
    if (IN(2)) { const float* part = (const float*)(ws + WS_PART); float* gb = (float*)(ws + WS_GB);
        for (int e = bid * 512 + (int)threadIdx.x; e < 2 * NSA_PAD; e += G * 512) { const int which = e / NSA_PAD, c = e - which * NSA_PAD; float t = 0.f;
#pragma unroll 8
            for (int ks = 0; ks < 32; ++ks) t += part[(size_t)(ks * 2 + which) * NSA_PAD + c];
            gb[e] = t; } }
    if (IN(2)) {
        const pg8::Geom g{1024, 1024, 1024, 128, 128, 128 * 1024 * 2, 128 * 1024 * 2};
        SchedZU S{G, bid, XB, (const char*)(ws + WS_XP), (const char*)(ws + WS_WZT), (const char*)(ws + WS_WCT)};
        EpiZU E{(bf16_t*)(ws + WS_A), (bf16_t*)a.out};
        pg8::gemm_phase<EpiZU, SchedZU, true>(lds, g, S, E);
    }
    SEAM(2);
    if (IN(4)) {
        const pg8::Geom g{2048, 2048, 2048, 128, 128, 128 * 2048 * 2, 128 * 2048 * 2};
        SchedPlain S{MTOK / 256, 4, G, bid, (const char*)(ws + WS_A), (const char*)(ws + WS_WPOT), (size_t)256 * 2048 * 2, (size_t)256 * 2048 * 2};
        EpiRes0 E{(float*)(ws + WS_V), (bf16_t*)(ws + WS_XB), a.in[I_X], (float*)(ws + WS_STATS)};
        pg8::gemm_phase<EpiRes0, SchedPlain, true>(lds, g, S, E);
    }
    SEAM(4);
    if (IN(5)) { const float* ST = (const float*)(ws + WS_STATS); float* SF = (float*)(ws + WS_SF);
        for (int row = bid * 512 + (int)threadIdx.x; row < MTOK; row += G * 512) { const f32x4* p = (const f32x4*)(ST + (size_t)row * 32); float s_ = 0.f, q_ = 0.f;
#pragma unroll
            for (int j = 0; j < 8; ++j) { const f32x4 t = p[j]; s_ += t[0] + t[2]; q_ += t[1] + t[3]; }
            const float mean = s_ * (1.f / DM), var = q_ * (1.f / DM) - mean * mean; f32x2 o = {mean, 1.f / sqrtf(var + LN_EPS)}; *(f32x2*)(SF + (size_t)row * 2) = o; } }
    SEAM(5);
    if (IN(6)) {
        const pg8::Geom g{1024, 1024, 1024, 128, 128, 128 * 1024 * 2, 128 * 1024 * 2};
        EpiNsaIn E{(bf16_t*)(ws + WS_QB), (bf16_t*)(ws + WS_KV), (bf16_t*)(ws + WS_SZN), (float*)(ws + WS_GATE), (const float*)(ws + WS_SF), (const float*)(ws + WS_GB)};
        if (G == 256) { SchedNsaA S{G, bid, XB, (const char*)(ws + WS_WNIT)}; pg8::gemm_phase<EpiNsaIn, SchedNsaA, true>(lds, g, S, E); }
        else { SchedPlain S{MTOK / 256, NSA_PAD / 256, G, bid, XB, (const char*)(ws + WS_WNIT), (size_t)256 * 1024 * 2, (size_t)256 * 1024 * 2}; pg8::gemm_phase<EpiNsaIn, SchedPlain, true>(lds, g, S, E); }
    }
    SEAM(6);
    if (IN(7) && G == 256) {
        const pg8::Geom g{1024, 1024, 1024, 128, 128, 128 * 1024 * 2, 128 * 1024 * 2};
        EpiNsaIn E{(bf16_t*)(ws + WS_QB), (bf16_t*)(ws + WS_KV), (bf16_t*)(ws + WS_SZN), (float*)(ws + WS_GATE), (const float*)(ws + WS_SF), (const float*)(ws + WS_GB)};
        SchedNsaB S{bid, XB, (const char*)(ws + WS_WNIT)}; pg8::gemm_phase<EpiNsaIn, SchedNsaB, true>(lds, g, S, E);
    }
    if (IN(7)) {
        const pg8::Geom g{2048, 4096, 2048, 512, 128, 128, 128 * 2048 * 2};
        SchedCmp1 S{G, bid, (const char*)(ws + WS_KV), (const char*)(ws + WS_W1T)};
        EpiHid E{(bf16_t*)(ws + WS_HID), (const float*)(ws + WS_BIAS)};
        pg8::gemm_phase<EpiHid, SchedCmp1, false>(lds, g, S, E);
        asm volatile("s_waitcnt vmcnt(0)" ::: "memory"); __syncthreads();
    }
    if (IN(8)) {
        const pg8::Geom g{256, 256, 256, 128, 128, 128 * 256 * 2, 128 * 256 * 2};
        SchedCmp2 S{G, bid, (const char*)(ws + WS_HID), (const char*)(ws + WS_W2T)};
        EpiCmp E{(bf16_t*)(ws + WS_CMP)};
        pg8::gemm_phase<EpiCmp, SchedCmp2, false>(lds, g, S, E);
    }
    SEAM(8);
    if (IN(9)) phase_attn(a, lds);
    SEAM(9);
    if (IN(10)) {
        const pg8::Geom g{1024, 1024, 1024, 128, 128, 128 * 1024 * 2, 128 * 1024 * 2};
        SchedPlain S{MTOK / 256, 4, G, bid, XB, (const char*)(ws + WS_WNOT), (size_t)256 * 1024 * 2, (size_t)256 * 1024 * 2};
        EpiBf16 E{(bf16_t*)(ws + WS_QB)};
        pg8::gemm_phase<EpiBf16, SchedPlain, true>(lds, g, S, E);
    }
    SEAM(10);
    if (IN(11)) phase_final((const float*)(ws + WS_V), (const float*)(ws + WS_SF), (const bf16_t*)(ws + WS_QB), a.out, a.in[I_LNG], a.in[I_LNB]);
#undef IN
#undef SEAM
}

extern "C" void kernel_launch(void* const* d_in, const int* in_sizes, int n_in, void* d_out, int out_size, void* d_ws, size_t ws_size, hipStream_t stream) {
    static int grid = 0;
    if (grid == 0) {
        if (n_in != 15 || out_size != MTOK * DM || ws_size < WS_END) { fprintf(stderr, "kernel_launch: unexpected problem shape (n_in %d, out %d, ws %zu)\n", n_in, out_size, ws_size); grid = -1; return; }
        int dev = 0, cus = 0, per_cu = 0;
        if (hipGetDevice(&dev) != hipSuccess || hipDeviceGetAttribute(&cus, hipDeviceAttributeMultiprocessorCount, dev) != hipSuccess) { grid = -1; return; }
        if (hipFuncSetAttribute((const void*)fwd_kernel, hipFuncAttributeMaxDynamicSharedMemorySize, LDS_BYTES) != hipSuccess) { fprintf(stderr, "kernel_launch: hipFuncSetAttribute failed\n"); grid = -1; return; }
        if (hipOccupancyMaxActiveBlocksPerMultiprocessor(&per_cu, (const void*)fwd_kernel, 512, LDS_BYTES) != hipSuccess || per_cu < 1) per_cu = 1;
        (void)hipGetLastError();
        grid = cus * per_cu;
    }
    if (grid < 0) return;
    if (hipMemsetAsync((char*)d_ws + WS_CTL, 0, 16384, stream) != hipSuccess) { fprintf(stderr, "kernel_launch: memset failed\n"); return; }
    Args a{};
    for (int i = 0; i < 15; ++i) a.in[i] = (const float*)d_in[i];
    a.out = (float*)d_out; a.ws = (unsigned char*)d_ws;
#if MK_SINGLE
    a.ph_lo = 0; a.ph_hi = N_PHASES;
    void* args[] = {&a};
    hipError_t e = hipLaunchCooperativeKernel((const void*)fwd_kernel, dim3(grid), dim3(512), args, LDS_BYTES, stream);
    if (e != hipSuccess) fprintf(stderr, "cooperative launch failed: %s (grid %d)\n", hipGetErrorString(e), grid);
#else
    for (int p = 0; p < N_PHASES; ++p) { a.ph_lo = p; a.ph_hi = p + 1;
        const int reps = ((REP_MASK >> p) & 1) ? 2 : 1;
        for (int r = 0; r < reps; ++r) hipLaunchKernelGGL(fwd_kernel, dim3(grid), dim3(512), LDS_BYTES, stream, a); }
#endif
}
```

```cpp
#include <hip/hip_runtime.h>
#include <hip/hip_cooperative_groups.h>
#include <cstdio>
#include <cstdint>
namespace cg = cooperative_groups;

#ifndef REP_MASK
#define REP_MASK 0
#endif
#ifndef MK_SINGLE
#define MK_SINGLE 1
#endif

#define LAS __attribute__((address_space(3)))
#define DI __device__ __forceinline__
typedef unsigned short bf16_t;
typedef short bf16x8 __attribute__((ext_vector_type(8)));
typedef short s16x4 __attribute__((ext_vector_type(4)));
typedef float f32x2 __attribute__((ext_vector_type(2)));
typedef float f32x4 __attribute__((ext_vector_type(4)));
typedef float f32x16 __attribute__((ext_vector_type(16)));
typedef unsigned u32x2 __attribute__((ext_vector_type(2)));
typedef unsigned u32x4 __attribute__((ext_vector_type(4)));
typedef __bf16 bf16x2_t __attribute__((ext_vector_type(2)));

constexpr int SEQ = 2048, NB = 16, DM = 1024, MTOK = NB * SEQ;
constexpr int DPOOL = 2048, NSA_IN = 3632, NSA_PAD = 3840;
constexpr int NCMP_PAD = 128;
constexpr float DN_ALPHA = 1.41421356237309515f;
constexpr float LN_EPS = 1e-5f;
constexpr float LOG2E = 1.4426950408889634f;

constexpr size_t MiB = 1u << 20;
constexpr size_t WS_CTL  = 0;
constexpr size_t WS_WINB = 1 * MiB;
constexpr size_t WS_WZT  = 5 * MiB;
constexpr size_t WS_WGT  = 9 * MiB;
constexpr size_t WS_WCT  = 11 * MiB;
constexpr size_t WS_WPOT = 15 * MiB;
constexpr size_t WS_WNIT = 19 * MiB;
constexpr size_t WS_W1T  = 27 * MiB;
constexpr size_t WS_W2T  = 29 * MiB;
constexpr size_t WS_WNOT = 30 * MiB;
constexpr size_t WS_BIAS = 32 * MiB;
constexpr size_t WS_STATS = 34 * MiB;
constexpr size_t WS_GB   = 33 * MiB;
constexpr size_t WS_SF   = 39 * MiB;
constexpr size_t WS_PART = 38 * MiB;
constexpr size_t WS_XB   = 40 * MiB;
constexpr size_t WS_XP   = 104 * MiB;
constexpr size_t WS_V    = 104 * MiB;
constexpr size_t WS_A    = 360 * MiB;
constexpr size_t WS_QB   = 232 * MiB;
constexpr size_t WS_SZN  = 296 * MiB;
constexpr size_t WS_KV   = 360 * MiB;
constexpr size_t WS_GATE = 456 * MiB;
constexpr size_t WS_HID  = 462 * MiB;
constexpr size_t WS_CMP  = 470 * MiB;
constexpr size_t WS_END  = 472 * MiB;

DI unsigned cvtpk(float lo, float hi) { f32x2 v = {lo, hi}; bf16x2_t b = __builtin_convertvector(v, bf16x2_t); return __builtin_bit_cast(unsigned, b); }
DI float bf_lo(unsigned u) { return __builtin_bit_cast(float, u << 16); }
DI float bf_hi(unsigned u) { return __builtin_bit_cast(float, u & 0xffff0000u); }
DI float fexp2(float x) { return __builtin_amdgcn_exp2f(x); }
DI float sigmoid_f(float v) { return __builtin_amdgcn_rcpf(1.f + fexp2(-v * LOG2E)); }
DI float silu_f(float v) { return v * sigmoid_f(v); }
DI float wave_sum(float v) {
#pragma unroll
    for (int o = 1; o < 64; o <<= 1) v += __shfl_xor(v, o);
    return v;
}
#define MFMA32(a, b, c) __builtin_amdgcn_mfma_f32_32x32x16_bf16((a), (b), (c), 0, 0, 0)

namespace pg8 {
constexpr int BM = 256, BK = 64, HALF = 128, HTB = HALF * BK * 2, STAGE_BYTES = 8 * HTB, NXCD = 8, WGM = 8;
DI int lds_byte(int r, int c) { const int st = (r >> 4) * 2 + (c >> 5), rr = r & 15, cc = c & 31, ob = rr * 64 + cc * 2; return st * 1024 + (ob ^ (((ob >> 9) & 1) << 5)); }
DI void stage_rc(int b, int& R, int& C) { const int st = b / 1024, sb = b % 1024, swz = sb ^ (((sb >> 9) & 1) << 5); R = (st >> 1) * 16 + swz / 64; C = (st & 1) * 32 + (swz % 64) / 2; }
DI int perm32(int rho) { const int n = rho >> 4, i = rho & 15; return 8 * (i >> 2) + 4 * n + (i & 3); }

struct Unit { const char* a; const char* b; int pm, pn; };
struct Geom { int K; unsigned lda, ldb; unsigned kstepA, kstepB; unsigned hstepA, hstepB; };

DI bool order_next(int nM, int nN, int G, int c, int i, int& pm, int& pn) {
    const int nwg = nM * nN; const long L = (long)i * G + c; if (L >= nwg) return false;
    int wgid = (int)L; { const int q = nwg / NXCD, r = nwg % NXCD, xcd = wgid % NXCD, off = wgid / NXCD; wgid = (xcd < r ? xcd * (q + 1) : r * (q + 1) + (xcd - r) * q) + off; }
    const int nig = WGM * nN, gid = wgid / nig, fm = gid * WGM, gsz = (nM - fm) < WGM ? (nM - fm) : WGM;
    pm = fm + ((wgid % nig) % gsz); pn = (wgid % nig) / gsz; return true;
}

DI void order_map(int nM, int nN, int L, int& pm, int& pn) {
    const int nwg = nM * nN; int wgid = L; { const int q = nwg / NXCD, r = nwg % NXCD, xcd = wgid % NXCD, off = wgid / NXCD; wgid = (xcd < r ? xcd * (q + 1) : r * (q + 1) + (xcd - r) * q) + off; }
    const int nig = WGM * nN, gid = wgid / nig, fm = gid * WGM, gsz = (nM - fm) < WGM ? (nM - fm) : WGM;
    pm = fm + ((wgid % nig) % gsz); pn = (wgid % nig) / gsz;
}
template <class Epi, class Sched, bool ALIGN_EPI>
DI void gemm_phase(LAS unsigned char* lds, const Geom g, const Sched& S, const Epi& E) {
    const int tid = threadIdx.x, wid = __builtin_amdgcn_readfirstlane(tid >> 6), lane = tid & 63, wr = wid >> 2, wc = wid & 3, fr = lane & 15, fq = lane >> 4;
    const int nt = g.K / BK;
    unsigned voffA[2], voffB[2];
#pragma unroll
    for (int i = 0; i < 2; ++i) { int R, C; stage_rc(tid * 16 + i * 8192, R, C); const int Rb = (R & ~31) + perm32(R & 31);
        voffA[i] = (unsigned)(R * g.lda + C) * 2u; voffB[i] = (unsigned)(Rb * g.ldb + C) * 2u; }
    const size_t kA = g.kstepA, kB = g.kstepB, hA = g.hstepA, hB = g.hstepB;
    const unsigned ldsw = (unsigned)wid * 1024u;
    const int aoff = lds_byte(wr * 64 + fr, fq * 8), boff = lds_byte(wc * 32 + fr, fq * 8);
#define PG8_SA(b, h) (((b) * 2 + (h)) * HTB)
#define PG8_SB(b, h) ((4 + (b) * 2 + (h)) * HTB)
#define PG8_STAGE(bufoff, gbase, voff) do { _Pragma("unroll") for (int _i = 0; _i < 2; ++_i) \
        __builtin_amdgcn_global_load_lds((const unsigned*)((const char*)(gbase) + (voff)[_i]), (LAS unsigned*)(lds + (bufoff) + ldsw + _i * 8192), 16, 0, 0); } while (0)
#define PG8_LDA(dst, b, h) do { _Pragma("unroll") for (int m = 0; m < 4; ++m) _Pragma("unroll") for (int k = 0; k < 2; ++k) dst[m][k] = *(const LAS bf16x8*)(lds + PG8_SA(b, h) + aoff + m * 2048 + k * 1024); } while (0)
#define PG8_LDB(dst, b, h) do { _Pragma("unroll") for (int n = 0; n < 2; ++n) _Pragma("unroll") for (int k = 0; k < 2; ++k) dst[n][k] = *(const LAS bf16x8*)(lds + PG8_SB(b, h) + boff + n * 2048 + k * 1024); } while (0)
#define PG8_MMA(ai, bj, At, Bt) do { __builtin_amdgcn_s_setprio(1); _Pragma("unroll") for (int m = 0; m < 4; ++m) _Pragma("unroll") for (int n = 0; n < 2; ++n) _Pragma("unroll") for (int k = 0; k < 2; ++k) \
        acc[ai][bj][m][n] = __builtin_amdgcn_mfma_f32_16x16x32_bf16(Bt[n][k], At[m][k], acc[ai][bj][m][n], 0, 0, 0); __builtin_amdgcn_s_setprio(0); } while (0)
#define PG8_WAIT_V(n) asm volatile("s_waitcnt vmcnt(" #n ")" ::: "memory")
#define PG8_WAIT_L(n) asm volatile("s_waitcnt lgkmcnt(" #n ")" ::: "memory")
#define PG8_BAR __builtin_amdgcn_s_barrier()
#define PG8_SCHED __builtin_amdgcn_sched_barrier(0)
    Unit cur, nxt; int ui = 0;
    if (!S.next(0, cur)) return;
    f32x4 acc[2][2][4][2];
#pragma unroll
    for (int a = 0; a < 2; ++a)
#pragma unroll
        for (int b = 0; b < 2; ++b)
#pragma unroll
            for (int m = 0; m < 4; ++m)
#pragma unroll
                for (int n = 0; n < 2; ++n) acc[a][b][m][n] = (f32x4){0.f, 0.f, 0.f, 0.f};
    bf16x8 At[4][2], B0[2][2], B1[2][2];
    const char* cA = cur.a; const char* cB = cur.b;
    PG8_STAGE(PG8_SB(0, 0), cB, voffB); PG8_STAGE(PG8_SB(0, 1), cB + hB, voffB); PG8_STAGE(PG8_SA(0, 0), cA, voffA); PG8_STAGE(PG8_SA(0, 1), cA + hA, voffA);
    if (wr == 1) PG8_BAR;
    PG8_WAIT_V(2); PG8_BAR;
    PG8_STAGE(PG8_SB(1, 0), cB + kB, voffB); PG8_STAGE(PG8_SA(1, 0), cA + kA, voffA); PG8_STAGE(PG8_SB(1, 1), cB + hB + kB, voffB);
    PG8_WAIT_V(6); PG8_BAR;
    for (;;) {
        const bool has_next = S.next(ui + 1, nxt);
        const char* nA = has_next ? nxt.a : cA; const char* nB = has_next ? nxt.b : cB;
        for (int t = 0; t < nt; t += 2) {
            const bool last = (t == nt - 2);
            const char* a1 = cA + (size_t)(t + 1) * kA;
            const char* a2 = last ? nA : cA + (size_t)(t + 2) * kA; const char* b2 = last ? nB : cB + (size_t)(t + 2) * kB;
            const char* a3 = a2 + kA; const char* b3 = b2 + kB;
            PG8_LDB(B0, 0, 0); PG8_LDB(B1, 0, 1); PG8_SCHED; PG8_LDA(At, 0, 0); PG8_STAGE(PG8_SA(1, 1), a1 + hA, voffA);
            PG8_WAIT_V(8); PG8_WAIT_L(0); PG8_BAR; PG8_MMA(0, 0, At, B0); PG8_MMA(0, 1, At, B1); PG8_BAR; PG8_SCHED;
            PG8_LDA(At, 0, 1); PG8_STAGE(PG8_SB(0, 0), b2, voffB); PG8_STAGE(PG8_SB(0, 1), b2 + hB, voffB); PG8_STAGE(PG8_SA(0, 0), a2, voffA);
            PG8_WAIT_V(8); PG8_WAIT_L(0); PG8_BAR; PG8_MMA(1, 0, At, B0); PG8_MMA(1, 1, At, B1); PG8_BAR; PG8_SCHED;
            PG8_LDB(B0, 1, 0); PG8_LDB(B1, 1, 1); PG8_SCHED; PG8_LDA(At, 1, 0); PG8_STAGE(PG8_SA(0, 1), a2 + hA, voffA);
            PG8_WAIT_V(8); PG8_WAIT_L(0); PG8_BAR; PG8_MMA(0, 0, At, B0); PG8_MMA(0, 1, At, B1); PG8_BAR; PG8_SCHED;
            PG8_LDA(At, 1, 1); PG8_STAGE(PG8_SB(1, 0), b3, voffB); PG8_STAGE(PG8_SB(1, 1), b3 + hB, voffB); PG8_STAGE(PG8_SA(1, 0), a3, voffA);
            PG8_WAIT_V(8); PG8_WAIT_L(0); PG8_BAR; PG8_MMA(1, 0, At, B0); PG8_MMA(1, 1, At, B1); PG8_BAR; PG8_SCHED;
        }
        if constexpr (ALIGN_EPI) { if (wr == 0) PG8_BAR; }
        E(acc, cur, wr, wc, fr, fq);
        if (!has_next) break;
#pragma unroll
        for (int a = 0; a < 2; ++a)
#pragma unroll
            for (int b = 0; b < 2; ++b)
#pragma unroll
                for (int m = 0; m < 4; ++m)
#pragma unroll
                    for (int n = 0; n < 2; ++n) acc[a][b][m][n] = (f32x4){0.f, 0.f, 0.f, 0.f};
        cur = nxt; cA = nA; cB = nB; ++ui;
        if constexpr (ALIGN_EPI) { if (wr == 1) PG8_BAR; }
    }
    PG8_WAIT_V(0);
    if constexpr (!ALIGN_EPI) { if (wr == 0) PG8_BAR; }
    PG8_BAR;
#undef PG8_SA
#undef PG8_SB
#undef PG8_STAGE
#undef PG8_LDA
#undef PG8_LDB
#undef PG8_MMA
#undef PG8_WAIT_V
#undef PG8_WAIT_L
#undef PG8_BAR
#undef PG8_SCHED
}
}
using pg8::Unit;
typedef f32x4 Acc[2][2][4][2];

DI void st8_bf16(bf16_t* p, f32x4 v0, f32x4 v1) { u32x4 w; w.x = cvtpk(v0[0], v0[1]); w.y = cvtpk(v0[2], v0[3]); w.z = cvtpk(v1[0], v1[1]); w.w = cvtpk(v1[2], v1[3]); *(u32x4*)p = w; }

struct SchedPlain {
    int nM, nN, G, c; const char* A; const char* B; size_t atile, btile;
    DI bool next(int i, Unit& u) const { int pm, pn; if (!pg8::order_next(nM, nN, G, c, i, pm, pn)) return false; u.pm = pm; u.pn = pn; u.a = A + (size_t)pm * atile; u.b = B + (size_t)pn * btile; return true; }
};
struct SchedU {
    int nM, nN, G, c; const char* A; const char* B; size_t atile, btile, agroup;
    DI bool next(int i, Unit& u) const { int pm, pn; if (!pg8::order_next(nM, nN, G, c, i, pm, pn)) return false; u.pm = pm; u.pn = pn; u.a = A + (size_t)(pn >> 1) * agroup + (size_t)pm * atile; u.b = B + (size_t)pn * btile; return true; }
};
struct SchedNsaA {
    int G, c; const char* A; const char* B;
    DI bool next(int i, Unit& u) const { int pm, pn; if (!pg8::order_next(MTOK / 256, 2, G, c, i, pm, pn)) return false; u.pm = pm; u.pn = pn + 4; u.a = A + (size_t)pm * (256 * 1024 * 2); u.b = B + (size_t)(pn + 4) * (256 * 1024 * 2); return true; }
};
struct SchedNsaB {
    int c; const char* A; const char* B;
    DI bool next(int i, Unit& u) const {
        int L;
        if (c < 64) { if (i >= 5) return false; L = i * 256 + c; }
        else if (c < 192) { if (i < 6) L = i * 256 + c; else if (i == 6) L = 1536 + (c - 64); else return false; }
        else { if (i < 6) L = i * 256 + c; else if (i == 6) L = 1280 + (c - 192); else return false; }
        int pm, pn; pg8::order_map(MTOK / 256, 13, L, pm, pn); pn = pn < 4 ? pn : pn + 2;
        u.pm = pm; u.pn = pn; u.a = A + (size_t)pm * (256 * 1024 * 2); u.b = B + (size_t)pn * (256 * 1024 * 2); return true; }
};
struct SchedZU {
    int G, c; const char* XBp; const char* XPp; const char* WZ; const char* WC;
    DI bool next(int i, Unit& u) const { int pm, pn; if (!pg8::order_next(MTOK / 256, 8, G, c, i >> 1, pm, pn)) return false; u.pm = pm;
        if ((i & 1) == 0) { u.pn = pn + 8; u.a = XBp + (size_t)pm * (256 * 1024 * 2); u.b = WZ + (size_t)pn * (256 * 1024 * 2); }
        else { u.pn = pn; u.a = XPp + (size_t)(pn >> 1) * ((size_t)MTOK * 1024 * 2) + (size_t)pm * (256 * 1024 * 2); u.b = WC + (size_t)pn * (256 * 1024 * 2); }
        return true; }
};
struct SchedWc {
    int G, c; const char* A; const char* B;
    DI bool next(int i, Unit& u) const { int pm, pn; if (!pg8::order_next(8, 4, G, c, i, pm, pn)) return false; u.pm = pm; u.pn = pn; u.a = A + (size_t)pm * (256 * 512 * 2); u.b = B + (size_t)pn * (256 * 2048 * 2) + (size_t)(pm >> 1) * 1024; return true; }
};
struct SchedCmp1 {
    int G, c; const char* KV; const char* W1;
    DI bool next(int i, Unit& u) const { int pm, pn; if (!pg8::order_next(64, 1, G, c, i, pm, pn)) return false; u.pm = pm; u.pn = 0;
        const int kv = pm >> 5, rt = pm & 31, b = rt >> 1, g0 = (rt & 1) * 2;
        u.a = KV + (size_t)kv * ((size_t)MTOK * 256 * 2) + ((size_t)b * SEQ * 256 + g0 * 64) * 2; u.b = W1 + (size_t)kv * (256 * 2048 * 2); return true; }
};
struct SchedCmp2 {
    int G, c; const char* H; const char* W2;
    DI bool next(int i, Unit& u) const { int pm, pn; if (!pg8::order_next(64, 1, G, c, i, pm, pn)) return false; u.pm = pm; u.pn = 0;
        u.a = H + (size_t)pm * (256 * 256 * 2); u.b = W2 + (size_t)(pm >> 5) * (256 * 256 * 2); return true; }
};

#define EPI_LOOP_ROWS for (int ai = 0; ai < 2; ++ai) for (int m = 0; m < 4; ++m)
struct EpiSilu {
    bf16_t* O; int ld;
    DI void operator()(const Acc& acc, const Unit& u, int wr, int wc, int fr, int fq) const {
        const int row0 = u.pm * 256 + wr * 64 + fr, col0 = u.pn * 256 + wc * 32 + 8 * fq;
#pragma unroll
        EPI_LOOP_ROWS { bf16_t* rp = O + (size_t)(row0 + ai * 128 + m * 16) * ld + col0;
#pragma unroll
            for (int bj = 0; bj < 2; ++bj) { f32x4 v0 = acc[ai][bj][m][0], v1 = acc[ai][bj][m][1];
#pragma unroll
                for (int e = 0; e < 4; ++e) { v0[e] = silu_f(v0[e]); v1[e] = silu_f(v1[e]); }
                st8_bf16(rp + bj * 128, v0, v1); } }
    }
};
struct EpiMulSz {
    bf16_t* O; const bf16_t* SZ; int ld;
    DI void operator()(const Acc& acc, const Unit& u, int wr, int wc, int fr, int fq) const {
        const int row0 = u.pm * 256 + wr * 64 + fr, col0 = u.pn * 256 + wc * 32 + 8 * fq;
#pragma unroll
        EPI_LOOP_ROWS { const size_t off = (size_t)(row0 + ai * 128 + m * 16) * ld + col0;
#pragma unroll
            for (int bj = 0; bj < 2; ++bj) { f32x4 v0 = acc[ai][bj][m][0], v1 = acc[ai][bj][m][1]; const u32x4 s = *(const u32x4*)(SZ + off + bj * 128);
                v0[0] *= bf_lo(s.x); v0[1] *= bf_hi(s.x); v0[2] *= bf_lo(s.y); v0[3] *= bf_hi(s.y); v1[0] *= bf_lo(s.z); v1[1] *= bf_hi(s.z); v1[2] *= bf_lo(s.w); v1[3] *= bf_hi(s.w);
                st8_bf16(O + off + bj * 128, v0, v1); } }
    }
};
DI void row_stats(const float* SF, int row, float& mean, float& rstd) { const f32x2 t = *(const f32x2*)(SF + (size_t)row * 2); mean = t[0]; rstd = t[1]; }
struct EpiZU {
    bf16_t* O; bf16_t* SZ;
    DI void operator()(const Acc& acc, const Unit& u, int wr, int wc, int fr, int fq) const {
        const bool isz = u.pn >= 8; const int row0 = u.pm * 256 + wr * 64 + fr, col0 = (isz ? u.pn - 8 : u.pn) * 256 + wc * 32 + 8 * fq;
        if (isz) {
#pragma unroll
            EPI_LOOP_ROWS { bf16_t* rp = SZ + (size_t)(row0 + ai * 128 + m * 16) * 2048 + col0;
#pragma unroll
                for (int bj = 0; bj < 2; ++bj) { f32x4 v0 = acc[ai][bj][m][0], v1 = acc[ai][bj][m][1];
#pragma unroll
                    for (int e = 0; e < 4; ++e) { v0[e] = silu_f(v0[e]); v1[e] = silu_f(v1[e]); }
                    st8_bf16(rp + bj * 128, v0, v1); } }
        } else {
            u32x4 zz[2][4][2];
#pragma unroll
            EPI_LOOP_ROWS {
#pragma unroll
                for (int bj = 0; bj < 2; ++bj) zz[ai][m][bj] = *(const u32x4*)(SZ + (size_t)(row0 + ai * 128 + m * 16) * 2048 + col0 + bj * 128); }
            __builtin_amdgcn_sched_barrier(0);
#pragma unroll
            EPI_LOOP_ROWS { const size_t off = (size_t)(row0 + ai * 128 + m * 16) * 2048 + col0;
#pragma unroll
                for (int bj = 0; bj < 2; ++bj) { f32x4 v0 = acc[ai][bj][m][0], v1 = acc[ai][bj][m][1]; const u32x4 z = zz[ai][m][bj];
                    v0[0] *= bf_lo(z.x); v0[1] *= bf_hi(z.x); v0[2] *= bf_lo(z.y); v0[3] *= bf_hi(z.y); v1[0] *= bf_lo(z.z); v1[1] *= bf_hi(z.z); v1[2] *= bf_lo(z.w); v1[3] *= bf_hi(z.w);
                    st8_bf16(O + off + bj * 128, v0, v1); } }
        }
    }
};
struct EpiRes0 {
    float* O; bf16_t* OB; const float* R; float* ST;
    DI void operator()(const Acc& acc, const Unit& u, int wr, int wc, int fr, int fq) const {
        const int row0 = u.pm * 256 + wr * 64 + fr, col0 = u.pn * 256 + wc * 32 + 8 * fq;
#pragma unroll
        for (int ai = 0; ai < 2; ++ai) {
            f32x4 xr[4][2][2];
#pragma unroll
            for (int m = 0; m < 4; ++m)
#pragma unroll
                for (int bj = 0; bj < 2; ++bj) { const float* rp = R + (size_t)(row0 + ai * 128 + m * 16) * DM + col0 + bj * 128;
                    xr[m][bj][0] = __builtin_nontemporal_load((const f32x4*)rp); xr[m][bj][1] = __builtin_nontemporal_load((const f32x4*)(rp + 4)); }
            __builtin_amdgcn_sched_barrier(0);
#pragma unroll
            for (int m = 0; m < 4; ++m) { const int row = row0 + ai * 128 + m * 16; const size_t off = (size_t)row * DM + col0; float s = 0.f, q = 0.f;
#pragma unroll
                for (int bj = 0; bj < 2; ++bj) {
                    const f32x4 v0 = xr[m][bj][0] * DN_ALPHA + acc[ai][bj][m][0], v1 = xr[m][bj][1] * DN_ALPHA + acc[ai][bj][m][1];
                    __builtin_nontemporal_store(v0, (f32x4*)(O + off + bj * 128)); __builtin_nontemporal_store(v1, (f32x4*)(O + off + bj * 128 + 4)); st8_bf16(OB + off + bj * 128, v0, v1);
                    s += ((v0[0] + v0[1]) + (v0[2] + v0[3])) + ((v1[0] + v1[1]) + (v1[2] + v1[3]));
                    q += ((v0[0] * v0[0] + v0[1] * v0[1]) + (v0[2] * v0[2] + v0[3] * v0[3])) + ((v1[0] * v1[0] + v1[1] * v1[1]) + (v1[2] * v1[2] + v1[3] * v1[3])); }
                s += __shfl_xor(s, 16); q += __shfl_xor(q, 16); s += __shfl_xor(s, 32); q += __shfl_xor(q, 32);
                if (fq == 0) { f32x2 o = {s, q}; *(f32x2*)(ST + (size_t)row * 32 + (u.pn * 4 + wc) * 2) = o; } }
        }
    }
};
struct EpiBf16 {
    bf16_t* O;
    DI void operator()(const Acc& acc, const Unit& u, int wr, int wc, int fr, int fq) const {
        const int row0 = u.pm * 256 + wr * 64 + fr, col0 = u.pn * 256 + wc * 32 + 8 * fq;
#pragma unroll
        EPI_LOOP_ROWS { bf16_t* rp = O + (size_t)(row0 + ai * 128 + m * 16) * DM + col0;
#pragma unroll
            for (int bj = 0; bj < 2; ++bj) st8_bf16(rp + bj * 128, acc[ai][bj][m][0], acc[ai][bj][m][1]); }
    }
};
struct EpiRes1 {
    float* O; const float* V; const float* SF; const float* gam; const float* bet;
    DI void operator()(const Acc& acc, const Unit& u, int wr, int wc, int fr, int fq) const {
        const int row0 = u.pm * 256 + wr * 64 + fr, col0 = u.pn * 256 + wc * 32 + 8 * fq;
        f32x4 g[2][2], bt[2][2];
#pragma unroll
        for (int bj = 0; bj < 2; ++bj) { const int c = col0 + bj * 128; g[bj][0] = *(const f32x4*)(gam + c); g[bj][1] = *(const f32x4*)(gam + c + 4); bt[bj][0] = *(const f32x4*)(bet + c); bt[bj][1] = *(const f32x4*)(bet + c + 4); }
#pragma unroll
        EPI_LOOP_ROWS { const int row = row0 + ai * 128 + m * 16; float mean, rstd; row_stats(SF, row, mean, rstd);
#pragma unroll
            for (int bj = 0; bj < 2; ++bj) { const size_t off = (size_t)row * DM + col0 + bj * 128;
                const f32x4 r0 = *(const f32x4*)(V + off), r1 = *(const f32x4*)(V + off + 4);
                const f32x4 x0 = (r0 - mean) * rstd * g[bj][0] + bt[bj][0], x1 = (r1 - mean) * rstd * g[bj][1] + bt[bj][1];
                *(f32x4*)(O + off) = x0 * DN_ALPHA + acc[ai][bj][m][0]; *(f32x4*)(O + off + 4) = x1 * DN_ALPHA + acc[ai][bj][m][1]; } }
    }
};
struct EpiWc {
    bf16_t* O; const float* scale;
    DI void operator()(const Acc& acc, const Unit& u, int wr, int wc, int fr, int fq) const {
        const int row0 = u.pm * 256 + wr * 64 + fr, col0 = u.pn * 256 + wc * 32 + 8 * fq;
#pragma unroll
        EPI_LOOP_ROWS { const int row = row0 + ai * 128 + m * 16; const float sc = scale[row];
#pragma unroll
            for (int bj = 0; bj < 2; ++bj) st8_bf16(O + (size_t)row * 1024 + col0 + bj * 128, acc[ai][bj][m][0] * sc, acc[ai][bj][m][1] * sc); }
    }
};
struct EpiNsaIn {
    bf16_t* Q; bf16_t* KV; bf16_t* SZ; float* GT; const float* SF; const float* GB;
    DI void operator()(const Acc& acc, const Unit& u, int wr, int wc, int fr, int fq) const {
        const int row0 = u.pm * 256 + wr * 64 + fr, cl0 = wc * 32 + 8 * fq, pn = u.pn;
        if (pn == 14 && cl0 >= 48) return;
        f32x4 Gv[2][2], Bv[2][2];
#pragma unroll
        for (int bj = 0; bj < 2; ++bj) { const int c = pn * 256 + bj * 128 + cl0; Gv[bj][0] = *(const f32x4*)(GB + c); Gv[bj][1] = *(const f32x4*)(GB + c + 4); Bv[bj][0] = *(const f32x4*)(GB + NSA_PAD + c); Bv[bj][1] = *(const f32x4*)(GB + NSA_PAD + c + 4); }
        f32x2 stt[2][4];
#pragma unroll
        EPI_LOOP_ROWS stt[ai][m] = *(const f32x2*)(SF + (size_t)(row0 + ai * 128 + m * 16) * 2);
        __builtin_amdgcn_sched_barrier(0);
#pragma unroll
        EPI_LOOP_ROWS { const int row = row0 + ai * 128 + m * 16; const float mean = stt[ai][m][0], rstd = stt[ai][m][1];
#pragma unroll
            for (int bj = 0; bj < 2; ++bj) {
                if (pn == 14 && bj == 1) break;
                f32x4 v0 = (acc[ai][bj][m][0] - Gv[bj][0] * mean) * rstd + Bv[bj][0], v1 = (acc[ai][bj][m][1] - Gv[bj][1] * mean) * rstd + Bv[bj][1];
                if (pn < 4) { v0 = v0 * (0.125f * LOG2E); v1 = v1 * (0.125f * LOG2E); st8_bf16(Q + (size_t)row * 1024 + pn * 256 + bj * 128 + cl0, v0, v1); }
                else if (pn < 10) { st8_bf16(KV + (size_t)(pn - 4) * ((size_t)MTOK * 256) + (size_t)row * 256 + bj * 128 + cl0, v0, v1); }
                else if (pn < 14) {
#pragma unroll
                    for (int e = 0; e < 4; ++e) { v0[e] = silu_f(v0[e]); v1[e] = silu_f(v1[e]); }
                    st8_bf16(SZ + (size_t)row * 1024 + (pn - 10) * 256 + bj * 128 + cl0, v0, v1); }
                else {
#pragma unroll
                    for (int e = 0; e < 4; ++e) { v0[e] = sigmoid_f(v0[e]); v1[e] = sigmoid_f(v1[e]); }
                    float* rp = GT + (size_t)row * 48 + cl0; *(f32x4*)rp = v0; *(f32x4*)(rp + 4) = v1; } } }
    }
};
struct EpiHid {
    bf16_t* O; const float* bias;
    DI void operator()(const Acc& acc, const Unit& u, int wr, int wc, int fr, int fq) const {
        const int row0 = u.pm * 256 + wr * 64 + fr, col0 = wc * 32 + 8 * fq; const float* bp = bias + (u.pm >> 5) * 256 + col0;
#pragma unroll
        for (int bj = 0; bj < 2; ++bj) { const f32x4 b0 = *(const f32x4*)(bp + bj * 128), b1 = *(const f32x4*)(bp + bj * 128 + 4);
#pragma unroll
            EPI_LOOP_ROWS { f32x4 v0 = acc[ai][bj][m][0] + b0, v1 = acc[ai][bj][m][1] + b1;
#pragma unroll
                for (int e = 0; e < 4; ++e) { v0[e] = silu_f(v0[e]); v1[e] = silu_f(v1[e]); }
                st8_bf16(O + (size_t)(row0 + ai * 128 + m * 16) * 256 + col0 + bj * 128, v0, v1); } }
    }
};
struct EpiCmp {
    bf16_t* O;
    DI void operator()(const Acc& acc, const Unit& u, int wr, int wc, int fr, int fq) const {
        if (wc >= 2) return;
        const int row0 = u.pm * 256 + wr * 64 + fr, col0 = wc * 32 + 8 * fq;
#pragma unroll
        EPI_LOOP_ROWS { const int row = row0 + ai * 128 + m * 16; f32x4 v0 = acc[ai][0][m][0], v1 = acc[ai][0][m][1];
            if ((row & 127) == 127) { v0 = (f32x4){0.f, 0.f, 0.f, 0.f}; v1 = v0; }
            st8_bf16(O + (size_t)row * 64 + col0, v0, v1); }
    }
};


#define XB_TMO      128
#define XB_XCNT(j)  (256  + 64 * (j))
#define XB_XSUB(j)  (1280 + 64 * (j))
#define XB_XGEN(j)  (2304 + 64 * (j))
#define XB_TOP      3328
#define XB_TOPGEN   3392
#define XCD_BAR_WORDS 3456
#define XB_SPIN_CAP (1u << 22)
DI unsigned xb_ld(unsigned* p)              { return __hip_atomic_load(p, __ATOMIC_RELAXED, __HIP_MEMORY_SCOPE_AGENT); }
DI unsigned xb_add(unsigned* p, unsigned v) { return __hip_atomic_fetch_add(p, v, __ATOMIC_RELAXED, __HIP_MEMORY_SCOPE_AGENT); }
DI unsigned xb_xcc_id() { return (unsigned)__builtin_amdgcn_s_getreg((3 << 11) | 20) & 0xFu; }
#define XB_SPIN(cond, bar) do { unsigned _sp = 0; while (cond) { __builtin_amdgcn_s_sleep(1); \
    if ((++_sp & 255u) == 0u) { if (xb_ld(&(bar)[XB_TMO])) break; if (_sp > XB_SPIN_CAP) { atomicAdd(&(bar)[XB_TMO], 1u); break; } } } } while (0)
struct XcdBarrier { unsigned* bar; unsigned x; volatile LAS unsigned* st; };
DI XcdBarrier xcd_barrier_post(unsigned* bar, volatile LAS unsigned* st) {
    XcdBarrier b; b.bar = bar; b.x = xb_xcc_id(); b.st = st;
    if (threadIdx.x == 0) (void)xb_add(&bar[XB_XCNT(b.x)], 1u);
    return b;
}
DI void xcd_barrier_complete(unsigned* bar, unsigned x, unsigned& nloc, unsigned& nx) {
    const unsigned G = gridDim.x * gridDim.y * gridDim.z;
    unsigned sum, cnt, mine, sp = 0u;
    for (;;) {
        sum = 0u; cnt = 0u; mine = 0u;
#pragma unroll
        for (unsigned j = 0; j < 16; ++j) { const unsigned c = xb_ld(&bar[XB_XCNT(j)]); sum += c; cnt += (c > 0u) ? 1u : 0u; mine = (j == x) ? c : mine; }
        if (sum == G) break;
        __builtin_amdgcn_s_sleep(1);
        if ((++sp & 255u) == 0u) { if (xb_ld(&bar[XB_TMO])) break; if (sp > XB_SPIN_CAP) { atomicAdd(&bar[XB_TMO], 1u); break; } }
    }
    nloc = mine > 0u ? mine : 1u; nx = cnt > 0u ? cnt : 1u;
}
DI void xcd_barrier(const XcdBarrier& b) {
    asm volatile("s_waitcnt vmcnt(0)" ::: "memory");
    __syncthreads();
    if (threadIdx.x == 0) {
        unsigned* bar = b.bar;
        __builtin_amdgcn_s_waitcnt(0);
        unsigned nloc = b.st[0], nx = b.st[1];
        if (nloc == 0u) { xcd_barrier_complete(bar, b.x, nloc, nx); b.st[0] = nloc; b.st[1] = nx; }
        const unsigned old = xb_add(&bar[XB_XSUB(b.x)], 1u);
        const unsigned gen = old / nloc;
        if (old + 1u == (gen + 1u) * nloc) {
            __builtin_amdgcn_fence(__ATOMIC_RELEASE, "agent");
            asm volatile("s_waitcnt vmcnt(0)" ::: "memory");
            const unsigned og = xb_add(&bar[XB_TOP], 1u);
            const unsigned tg = og / nx;
            if (og + 1u == (tg + 1u) * nx) xb_add(&bar[XB_TOPGEN], 1u);
            else XB_SPIN(xb_ld(&bar[XB_TOPGEN]) == tg, bar);
            __builtin_amdgcn_fence(__ATOMIC_ACQUIRE, "agent");
            xb_add(&bar[XB_XGEN(b.x)], 1u);
            asm volatile("s_waitcnt vmcnt(0)" ::: "memory");
        } else {
            XB_SPIN(xb_ld(&bar[XB_XGEN(b.x)]) == gen, bar);
            __builtin_amdgcn_fence(__ATOMIC_ACQUIRE, "agent");
            asm volatile("s_waitcnt vmcnt(0)" ::: "memory");
        }
    }
    __syncthreads();
}

struct Args { const float* in[15]; float* out; unsigned char* ws; int ph_lo, ph_hi; };
enum { I_X = 0, I_LNG, I_LNB, I_PWIN, I_PWGRP, I_PSCALE, I_PWOUT, I_NWIN, I_POSK, I_W1K, I_W2K, I_POSV, I_W1V, I_W2V, I_NWOUT };

DI void transpose_item(const float* W, int ldw, int Nsrc, int Npad, bf16_t* WT, int ldt, LAS float* scr, int item, int lane, const float* rs = nullptr) {
    const int nblk = Npad / 32, kb = item / nblk, nb = item % nblk, k0 = 64 * kb, n0 = 32 * nb;
    const int nn = n0 + (lane & 31); const bool ok = nn < Nsrc;
#pragma unroll 8
    for (int i = 0; i < 32; ++i) { const int kk = 2 * i + (lane >> 5); scr[kk * 33 + (lane & 31)] = ok ? W[(size_t)(k0 + kk) * ldw + nn] * (rs ? rs[k0 + kk] : 1.f) : 0.f; }
    asm volatile("s_waitcnt lgkmcnt(0)" ::: "memory");
    const int c = lane & 7;
#pragma unroll
    for (int j = 0; j < 4; ++j) { const int n = (lane >> 3) + 8 * j; const LAS float* s = scr + (8 * c) * 33 + n;
        u32x4 o; o.x = cvtpk(s[0 * 33], s[1 * 33]); o.y = cvtpk(s[2 * 33], s[3 * 33]); o.z = cvtpk(s[4 * 33], s[5 * 33]); o.w = cvtpk(s[6 * 33], s[7 * 33]);
        *(u32x4*)(WT + (size_t)(n0 + n) * ldt + k0 + 8 * c) = o; }
    asm volatile("s_waitcnt lgkmcnt(0)" ::: "memory");
}

DI void phase_convert(const Args& a, LAS unsigned char* lds, int skip, bool with_wc_ops) {
    unsigned char* ws = a.ws;
    const int tid = threadIdx.x, lane = tid & 63, wave = __builtin_amdgcn_readfirstlane(tid >> 6);
    if ((int)blockIdx.x < skip) return;
    const int G = gridDim.x - skip, gw = ((int)blockIdx.x - skip) * 8 + wave, NGW = G * 8, bidc = (int)blockIdx.x - skip;
    LAS float* scr = (LAS float*)(lds + wave * 16384);
    constexpr int J0 = 16 * 64, J1 = 32 * 32, J2 = 16 * 120, J3 = 32 * 8, J5 = 4 * 8, J7 = 16 * 32, J8 = 8 * 16;
    constexpr int NIT0 = J0 + J1 + J2 + 2 * J3 + 2 * J5 + J7;
    const int NIT = NIT0 + (with_wc_ops ? 4 * J8 : 0);
    for (int it = gw; it < NIT; it += NGW) {
        int r = it;
        if (r < J0) { transpose_item(a.in[I_PWIN] + 2048, 4096, 2048, 2048, (bf16_t*)(ws + WS_WZT), 1024, scr, r, lane); continue; } r -= J0;
        if (r < J1) { transpose_item(a.in[I_PWOUT], 1024, 1024, 1024, (bf16_t*)(ws + WS_WPOT), 2048, scr, r, lane); continue; } r -= J1;
        if (r < J2) { transpose_item(a.in[I_NWIN], NSA_IN, NSA_IN, NSA_PAD, (bf16_t*)(ws + WS_WNIT), 1024, scr, r, lane, a.in[I_LNG]); continue; } r -= J2;
        if (r < J3) { transpose_item(a.in[I_W1K], 256, 256, 256, (bf16_t*)(ws + WS_W1T), 2048, scr, r, lane); continue; } r -= J3;
        if (r < J3) { transpose_item(a.in[I_W1V], 256, 256, 256, (bf16_t*)(ws + WS_W1T) + 256 * 2048, 2048, scr, r, lane); continue; } r -= J3;
        if (r < J5) { transpose_item(a.in[I_W2K], 64, 64, 256, (bf16_t*)(ws + WS_W2T), 256, scr, r, lane); continue; } r -= J5;
        if (r < J5) { transpose_item(a.in[I_W2V], 64, 64, 256, (bf16_t*)(ws + WS_W2T) + 256 * 256, 256, scr, r, lane); continue; } r -= J5;
        if (r < J7) { transpose_item(a.in[I_NWOUT], 1024, 1024, 1024, (bf16_t*)(ws + WS_WNOT), 1024, scr, r, lane); continue; } r -= J7;
        { const int g = r / J8; r -= g * J8; transpose_item(a.in[I_PWGRP] + (size_t)g * 512 * 512, 512, 512, 512, (bf16_t*)(ws + WS_WGT) + (size_t)g * 512 * 512, 512, scr, r, lane); }
    }
    { const float* W = a.in[I_PWIN]; bf16_t* O = (bf16_t*)(ws + WS_WINB);
      if (with_wc_ops) for (int e = bidc * 512 + tid; e < 1024 * 512; e += G * 512) { const int k = e >> 9, c4 = (e & 511) * 4; const f32x4 v = *(const f32x4*)(W + (size_t)k * 4096 + c4);
          u32x2 o; o.x = cvtpk(v[0], v[1]); o.y = cvtpk(v[2], v[3]); *(u32x2*)(O + (size_t)k * 2048 + c4) = o; } }
    for (int wi = gw; wi < (NSA_PAD / 64) * 32; wi += NGW) {
        const int chunk = wi % (NSA_PAD / 64), ks = wi / (NSA_PAD / 64), c = chunk * 64 + lane;
        const float* W = a.in[I_NWIN]; const float* gam = a.in[I_LNG]; const float* bet = a.in[I_LNB];
        float sg = 0.f, sb = 0.f;
        if (c < NSA_IN) {
#pragma unroll
            for (int j = 0; j < 32; ++j) { const int k = ks * 32 + j; const float wv = W[(size_t)k * NSA_IN + c]; sg += gam[k] * wv; sb += bet[k] * wv; } }
        float* part = (float*)(ws + WS_PART); part[(size_t)(ks * 2) * NSA_PAD + c] = sg; part[(size_t)(ks * 2 + 1) * NSA_PAD + c] = sb;
    }
    for (int wi = gw; wi < 64; wi += NGW) {
        const int kv = wi >> 5, n0 = (wi & 31) * 8, kk = lane >> 3, nn = lane & 7;
        const float* pos = a.in[kv ? I_POSV : I_POSK]; const float* w1 = a.in[kv ? I_W1V : I_W1K];
        float s = 0.f;
        for (int j = 0; j < 256; ++j) { const int k = kk + 8 * j; s += pos[k] * w1[(size_t)k * 256 + n0 + nn]; }
        s += __shfl_xor(s, 8); s += __shfl_xor(s, 16); s += __shfl_xor(s, 32);
        if (lane < 8) ((float*)(ws + WS_BIAS))[kv * 256 + n0 + nn] = s;
    }
}

struct SchedOne { const char* A; const char* B; int pm, pn; DI bool next(int i, Unit& u) const { if (i) return false; u.pm = pm; u.pn = pn; u.a = A; u.b = B; return true; } };
DI void wc_unit(const Args& a, LAS unsigned char* lds, int unit) {
    const int tid = threadIdx.x, lane = tid & 63, wave = __builtin_amdgcn_readfirstlane(tid >> 6);
    const int pm = unit >> 2, pn = unit & 3, g = pm >> 1, d0 = (pm & 1) * 256, k0 = pn * 256;
    bf16_t* Ap = (bf16_t*)(a.ws + WS_A) + (size_t)unit * (2 * 256 * 512);
    bf16_t* Bp = Ap + 256 * 512;
    LAS float* scr = (LAS float*)(lds + wave * 16384);
    for (int it = wave; it < 8 * 8; it += 8) transpose_item(a.in[I_PWGRP] + (size_t)g * 512 * 512 + d0, 512, 256, 256, Ap, 512, scr, it, lane);
    { const float* W = a.in[I_PWIN] + (size_t)k0 * 4096 + g * 512;
      for (int e = tid; e < 256 * 128; e += 512) { const int k = e >> 7, c4 = (e & 127) * 4; const f32x4 v = *(const f32x4*)(W + (size_t)k * 4096 + c4);
          u32x2 o; o.x = cvtpk(v[0], v[1]); o.y = cvtpk(v[2], v[3]); *(u32x2*)(Bp + (size_t)k * 512 + c4) = o; } }
    asm volatile("s_waitcnt vmcnt(0) lgkmcnt(0)" ::: "memory"); __syncthreads();
    const pg8::Geom gm{512, 512, 512, 128, 128, 128 * 512 * 2, 128 * 512 * 2};
    SchedOne S{(const char*)Ap, (const char*)Bp, pm, pn};
    EpiWc E{(bf16_t*)(a.ws + WS_WCT), a.in[I_PSCALE]};
    pg8::gemm_phase<EpiWc, SchedOne, false>(lds, gm, S, E);
}

#define POOL_LOAD(ARR, ROW0, GUARD) _Pragma("unroll") for (int j_ = 0; j_ < 8; ++j_) { ARR[j_] = (GUARD) ? __builtin_nontemporal_load((const f32x4*)(xp + (ptrdiff_t)((ROW0) + j_) * DM)) : (f32x4){0.f, 0.f, 0.f, 0.f}; }
#define POOL_INV(W, TL) ((edge_ && (TL) + 1 < (W)) ? 1.f / (float)((TL) + 1) : 1.f / (float)(W))
#define POOL_ST(PTR, V) { const f32x4 m_ = (V); u32x2 o_; o_.x = cvtpk(m_[0], m_[1]); o_.y = cvtpk(m_[2], m_[3]); __builtin_nontemporal_store(o_, (u32x2*)(PTR)); }
#define POOL_PROC(H0, H1, C, ROW0) { \
    _Pragma("unroll") for (int j_ = 0; j_ < 8; ++j_) { \
        const f32x4 x_ = C[j_]; const f32x4 p1_ = j_ >= 1 ? C[j_ >= 1 ? j_ - 1 : 0] : H1[7]; \
        const f32x4 W2 = p1_ + x_, W4 = S4 + x_, W8 = S8 + x_, W16 = S16 + x_; \
        const int tl_ = (ROW0) + j_; const size_t off_ = (size_t)(t0 + tl_) * DM + c4; \
        POOL_ST(XB + off_, x_) \
        POOL_ST(XP + off_, W2 * POOL_INV(2, tl_) - x_) \
        POOL_ST(XP + (size_t)MTOK * DM + off_, W4 * POOL_INV(4, tl_) - x_) \
        POOL_ST(XP + (size_t)2 * MTOK * DM + off_, W8 * POOL_INV(8, tl_) - x_) \
        POOL_ST(XP + (size_t)3 * MTOK * DM + off_, W16 * POOL_INV(16, tl_) - x_) \
        S4 = W4 - (j_ >= 3 ? C[j_ >= 3 ? j_ - 3 : 0] : H1[j_ < 3 ? j_ + 5 : 0]); S8 = W8 - (j_ >= 7 ? C[0] : H1[j_ < 7 ? j_ + 1 : 0]); S16 = W16 - (j_ >= 7 ? H1[0] : H0[j_ < 7 ? j_ + 1 : 0]); } }
DI void phase_pool(const Args& a, int blk, int nblk) {
    const float* X = a.in[I_X]; bf16_t* XB = (bf16_t*)(a.ws + WS_XB); bf16_t* XP = (bf16_t*)(a.ws + WS_XP);
    const int nitems = (MTOK / 64) * 256;
    for (int it = blk * 512 + (int)threadIdx.x; it < nitems; it += nblk * 512) {
        const int chunk = it >> 8, c4 = (it & 255) * 4, t0 = chunk * 64, tl0 = t0 & (SEQ - 1);
        const bool edge_ = tl0 == 0;
        const float* xp = X + (size_t)t0 * DM + c4;
        f32x4 A[8], B[8], C[8], D[8];
        POOL_LOAD(A, -16, !edge_)
        POOL_LOAD(B, -8, !edge_)
        POOL_LOAD(C, 0, true)
        POOL_LOAD(D, 8, true)
        f32x4 S16 = A[1], S8 = B[1], S4 = B[5] + B[6] + B[7];
#pragma unroll
        for (int j = 2; j < 8; ++j) { S16 = S16 + A[j]; S8 = S8 + B[j]; }
        S16 = S16 + B[0] + S8;
        POOL_PROC(A, B, C, 0)  POOL_LOAD(A, 16, true)
        POOL_PROC(B, C, D, 8)  POOL_LOAD(B, 24, true)
        POOL_PROC(C, D, A, 16) POOL_LOAD(C, 32, true)
        POOL_PROC(D, A, B, 24) POOL_LOAD(D, 40, true)
        POOL_PROC(A, B, C, 32) POOL_LOAD(A, 48, true)
        POOL_PROC(B, C, D, 40) POOL_LOAD(B, 56, true)
        POOL_PROC(C, D, A, 48)
        POOL_PROC(D, A, B, 56)
    }
}
#undef POOL_LOAD
#undef POOL_INV
#undef POOL_ST
#undef POOL_PROC

DI void phase_ln(const float* V, float* O, bf16_t* OB, const float* gam, const float* bet) {
    const int lane = threadIdx.x & 63, wave = threadIdx.x >> 6; const int gw = blockIdx.x * 8 + wave, NGW = gridDim.x * 8;
    f32x4 gg[4], bb[4];
#pragma unroll
    for (int j = 0; j < 4; ++j) { gg[j] = *(const f32x4*)(gam + 4 * lane + 256 * j); bb[j] = *(const f32x4*)(bet + 4 * lane + 256 * j); }
    for (int m = gw; m < MTOK; m += NGW) {
        const float* vr = V + (size_t)m * DM + 4 * lane; f32x4 v[4]; float s = 0.f;
#pragma unroll
        for (int j = 0; j < 4; ++j) { v[j] = *(const f32x4*)(vr + 256 * j); s += (v[j][0] + v[j][1]) + (v[j][2] + v[j][3]); }
        const float mean = wave_sum(s) * (1.f / DM); float s2 = 0.f;
#pragma unroll
        for (int j = 0; j < 4; ++j) { v[j] = v[j] - mean; s2 += (v[j][0] * v[j][0] + v[j][1] * v[j][1]) + (v[j][2] * v[j][2] + v[j][3] * v[j][3]); }
        const float rstd = 1.f / sqrtf(wave_sum(s2) * (1.f / DM) + LN_EPS);
#pragma unroll
        for (int j = 0; j < 4; ++j) { const f32x4 y = v[j] * rstd * gg[j] + bb[j]; *(f32x4*)(O + (size_t)m * DM + 4 * lane + 256 * j) = y;
            if (OB) { u32x2 o; o.x = cvtpk(y[0], y[1]); o.y = cvtpk(y[2], y[3]); *(u32x2*)(OB + (size_t)m * DM + 4 * lane + 256 * j) = o; } }
    }
}

DI void phase_final(const float* V, const float* SF, const bf16_t* Y1, float* O, const float* gam, const float* bet) {
    const int lane = threadIdx.x & 63, wave = threadIdx.x >> 6; const int gw = blockIdx.x * 8 + wave, NGW = gridDim.x * 8;
    f32x4 g0[4], b0[4], g1[4], b1[4];
#pragma unroll
    for (int j = 0; j < 4; ++j) { const int c = 4 * lane + 256 * j; g0[j] = *(const f32x4*)(gam + c); b0[j] = *(const f32x4*)(bet + c); g1[j] = *(const f32x4*)(gam + DM + c); b1[j] = *(const f32x4*)(bet + DM + c); }
    for (int m = gw; m < MTOK; m += NGW) {
        float mean0, rstd0; row_stats(SF, m, mean0, rstd0);
        f32x4 v[4]; float s = 0.f;
#pragma unroll
        for (int j = 0; j < 4; ++j) { const size_t off = (size_t)m * DM + 4 * lane + 256 * j; const f32x4 t = __builtin_nontemporal_load((const f32x4*)(V + off)); const u32x2 y = __builtin_nontemporal_load((const u32x2*)(Y1 + off));
            const f32x4 x1 = (t - mean0) * rstd0 * g0[j] + b0[j]; const f32x4 yv = {bf_lo(y.x), bf_hi(y.x), bf_lo(y.y), bf_hi(y.y)};
            v[j] = x1 * DN_ALPHA + yv; s += (v[j][0] + v[j][1]) + (v[j][2] + v[j][3]); }
        const float mean = wave_sum(s) * (1.f / DM); float s2 = 0.f;
#pragma unroll
        for (int j = 0; j < 4; ++j) { v[j] = v[j] - mean; s2 += (v[j][0] * v[j][0] + v[j][1] * v[j][1]) + (v[j][2] * v[j][2] + v[j][3] * v[j][3]); }
        const float rstd = 1.f / sqrtf(wave_sum(s2) * (1.f / DM) + LN_EPS);
#pragma unroll
        for (int j = 0; j < 4; ++j) __builtin_nontemporal_store(v[j] * rstd * g1[j] + b1[j], (f32x4*)(O + (size_t)m * DM + 4 * lane + 256 * j));
    }
}

constexpr int A_KT = 0, A_KT_SZ = 8192;
constexpr int A_VT = 3 * A_KT_SZ, A_VT_SZ = 8192;
constexpr int A_KC = A_VT + 3 * A_VT_SZ;
constexpr int A_VC = A_KC + 16384;
constexpr int A_IMP = 86016;
constexpr int A_TOT = A_IMP + 4 * 64 * 33 * 4;
constexpr int A_SEL = A_TOT + 8192;
constexpr int A_GATE = 132096;
static_assert(A_VC + 16384 <= A_IMP && A_SEL + 512 <= 131072 && A_GATE + 4096 <= 147456, "attention LDS map");
typedef short v4i16_t __attribute__((ext_vector_type(4)));
constexpr int NEGBITS = (int)0xF149F2CAu;
DI int crow(int i, int h) { return (i & 3) + 8 * (i >> 2) + 4 * h; }
DI bf16x8 pack8(const f32x16& x, int s) { u32x4 p; p.x = cvtpk(x[8 * s], x[8 * s + 1]); p.y = cvtpk(x[8 * s + 2], x[8 * s + 3]); p.z = cvtpk(x[8 * s + 4], x[8 * s + 5]); p.w = cvtpk(x[8 * s + 6], x[8 * s + 7]); return __builtin_bit_cast(bf16x8, p); }

DI void qk_tile(const LAS unsigned char* kb_, const bf16x8 (&qf)[4], const f32x16& AK, f32x16 (&S)[2], int r, int h) {
    const int kx = (r >> 1) & 7;
#pragma unroll
    for (int kb = 0; kb < 2; ++kb) {
#pragma unroll
        for (int s = 0; s < 4; ++s) { const bf16x8 kf = *(const LAS bf16x8*)(kb_ + (kb * 32 + r) * 128 + (((2 * s + h) ^ kx) << 4)); S[kb] = MFMA32(kf, qf[s], s == 0 ? AK : S[kb]); }
    }
}
DI void sm_pv_tile(f32x16 (&S)[2], const LAS unsigned char* vb_, f32x16 (&O)[2], float& mrun, float& lrun,
                   int kind, int n, int i, int tq, int qv, float slope2, unsigned selm, const int (&voff)[2][2],
                   bool do_qk, const LAS unsigned char* kn_, const bf16x8 (&qf)[4], const f32x16& AK, f32x16 (&SN)[2], int r, int h) {
    if (kind && __ballot(((selm >> n) & 1u) != 0u) == 0ull) { qk_tile(kn_, qf, AK, SN, r, h); return; }
    if (n == i || (kind == 0 && n == i - 4)) {
        const int flip = (n == i) ? 0 : -1;
#pragma unroll
        for (int kb = 0; kb < 2; ++kb)
#pragma unroll
            for (int e = 0; e < 16; ++e) { const int v = qv - (32 * kb + crow(e, 0)); S[kb][e] += __builtin_bit_cast(float, ((v ^ flip) >> 31) & NEGBITS); }
    }
    float mx0 = S[0][0], mx1 = S[1][0];
#pragma unroll
    for (int e = 1; e < 16; ++e) { mx0 = fmaxf(mx0, S[0][e]); mx1 = fmaxf(mx1, S[1][e]); }
    const float c32 = 32.f * slope2;
    float mx = fmaxf(mx0, mx1 + c32);
    mx = fmaxf(mx, __shfl_xor(mx, 32));
    const float ct = slope2 * (float)(tq - 64 * n);
    const bool qsel = kind ? ((selm >> n) & 1u) != 0u : true;
    const float mxt = qsel ? mx - ct : -1e30f;
    const bool need = mxt > mrun + 8.f;
    if (__ballot(need) != 0ull) {
        const float mnew = need ? mxt : mrun, alpha = fexp2(mrun - mnew); mrun = mnew; lrun *= alpha;
        O[0] = O[0] * alpha; O[1] = O[1] * alpha;
    }
    const float off = qsel ? mrun + ct : 1e30f;
    qk_tile(kn_, qf, AK, SN, r, h);
    float ls = 0.f;
#pragma unroll
    for (int kb = 0; kb < 2; ++kb)
#pragma unroll
        for (int e = 0; e < 16; ++e) { const float p = fexp2(S[kb][e] - (kb ? off - c32 : off)); S[kb][e] = p; ls += p; }
    lrun += ls;
#pragma unroll
    for (int kb = 0; kb < 2; ++kb)
#pragma unroll
        for (int s2 = 0; s2 < 2; ++s2) { const bf16x8 pb = pack8(S[kb], s2);
#pragma unroll
            for (int dt = 0; dt < 2; ++dt) { const LAS unsigned char* vp = vb_ + (32 * kb + 16 * s2) * 128;
                const s16x4 lo = __builtin_bit_cast(s16x4, __builtin_amdgcn_ds_read_tr16_b64_v4i16((LAS v4i16_t*)(vp + voff[dt][0])));
                const s16x4 hi = __builtin_bit_cast(s16x4, __builtin_amdgcn_ds_read_tr16_b64_v4i16((LAS v4i16_t*)(vp + voff[dt][1])));
                const bf16x8 vf = __builtin_shufflevector(lo, hi, 0, 1, 2, 3, 4, 5, 6, 7); O[dt] = MFMA32(vf, pb, O[dt]); } }
}
DI void tile_dma2(LAS unsigned char* dstK, LAS unsigned char* dstV, const bf16_t* Ksrc, const bf16_t* Vsrc, size_t base, int pitch, int w, int lane) {
    const int row = w * 8 + (lane >> 3), c = (lane & 7) ^ ((row >> 1) & 7);
    const size_t goff = base + (size_t)row * pitch + c * 8;
    __builtin_amdgcn_global_load_lds((const unsigned*)(Ksrc + goff), (LAS unsigned*)(dstK + w * 1024), 16, 0, 0);
    __builtin_amdgcn_global_load_lds((const unsigned*)(Vsrc + goff), (LAS unsigned*)(dstV + w * 1024), 16, 0, 0);
}
DI void cmp_dma(LAS unsigned char* lds, const bf16_t* CMP, int b, int g, int w, int lane) {
    const size_t base = (size_t)((b * 4 + g) * 128) * 64; const bf16_t* vc = CMP + (size_t)8192 * 64;
    tile_dma2(lds + A_KC, lds + A_VC, CMP, vc, base, 64, w, lane);
    tile_dma2(lds + A_KC + 8192, lds + A_VC + 8192, CMP, vc, base + 64 * 64, 64, w, lane);
}
DI void tile_dma(LAS unsigned char* lds, int bufi, const bf16_t* Ksrc, const bf16_t* Vsrc, size_t base, int w, int lane) {
    const int row = w * 8 + (lane >> 3), c = (lane & 7) ^ ((row >> 1) & 7);
    const size_t goff = base + (size_t)row * 256 + c * 8;
    __builtin_amdgcn_global_load_lds((const unsigned*)(Ksrc + goff), (LAS unsigned*)(lds + A_KT + bufi * A_KT_SZ + w * 1024), 16, 0, 0);
    __builtin_amdgcn_global_load_lds((const unsigned*)(Vsrc + goff), (LAS unsigned*)(lds + A_VT + bufi * A_VT_SZ + w * 1024), 16, 0, 0);
}

DI void attn_item(LAS unsigned char* lds, const bf16_t* QB, const bf16_t* KV, const bf16_t* CMP, const bf16_t* SZN, const float* GT, bf16_t* AO, int b, int i, int g, bool first, bool has_nx, int nxb, int nxg) {
    int tid_ = threadIdx.x; asm volatile("" : "+v"(tid_));
    const int tid = tid_, lane = tid & 63, w = __builtin_amdgcn_readfirstlane(tid >> 6), hh = w >> 1, qh = w & 1, r = lane & 31, h = lane >> 5;
    const int ql = 32 * qh + r, tq = 64 * i + ql, head = 4 * g + hh;
    const size_t row = (size_t)b * SEQ + tq;
    const bf16_t* KS = KV + (size_t)2 * MTOK * 256; const bf16_t* VS = KV + (size_t)3 * MTOK * 256;
    const bf16_t* KW = KV + (size_t)4 * MTOK * 256; const bf16_t* VW = KV + (size_t)5 * MTOK * 256;
    if (first) cmp_dma(lds, CMP, b, g, w, lane);
    if (tid == 0) ((LAS unsigned*)(lds + A_SEL))[64] = 0u;
    int voff[2][2];
    { const int q_ = (lane & 15) >> 2, p_ = lane & 3, blk_ = (lane >> 4) & 1, x_ = 2 * h + (q_ >> 1);
#pragma unroll
      for (int dt = 0; dt < 2; ++dt)
#pragma unroll
          for (int hi = 0; hi < 2; ++hi) voff[dt][hi] = (4 * h + q_ + 8 * hi) * 128 + (((4 * dt + 2 * blk_ + (p_ >> 1)) ^ (x_ ^ (4 * hi))) << 4) + (p_ & 1) * 8; }
    bf16x8 qf[4];
    { const bf16_t* qp = QB + row * 1024 + head * 64 + 8 * h;
#pragma unroll
      for (int s = 0; s < 4; ++s) qf[s] = *(const bf16x8*)(qp + 16 * s); }
    const float* gp = GT + row * 48 + head * 3; const float g0 = gp[0];
    { f32x2 g12 = {gp[1], gp[2]}; *(LAS f32x2*)(lds + A_GATE + tid * 8) = g12; }
    const float slope2 = fexp2(-0.5f * (float)(head + 1)) * LOG2E;
    __syncthreads();
    const size_t tbase = ((size_t)b * SEQ) * 256 + g * 64;
    tile_dma(lds, 0, KW, VW, tbase + (size_t)(64 * i) * 256, w, lane);
    if (i > 0) tile_dma(lds, 1, KW, VW, tbase + (size_t)(64 * (i - 1)) * 256, w, lane); else tile_dma(lds, 1, KS, VS, tbase, w, lane);
    f32x16 Oacc[2];
    {
        const int nkb = (i >> 3) + 1;
        f32x16 S[4];
        float mx = -1e30f;
#pragma unroll
        for (int kb = 0; kb < 4; ++kb) {
#pragma unroll
            for (int e = 0; e < 16; ++e) S[kb][e] = 0.f;
            if (kb < nkb) {
#pragma unroll
                for (int s = 0; s < 4; ++s) { const bf16x8 kf = *(const LAS bf16x8*)(lds + A_KC + (kb >> 1) * 8192 + ((kb & 1) * 32 + r) * 128 + (((2 * s + h) ^ ((r >> 1) & 7)) << 4)); S[kb] = MFMA32(kf, qf[s], S[kb]); }
#pragma unroll
                for (int e = 0; e < 16; ++e) { const int c = 32 * kb + crow(e, h); const int dist = tq - (16 * c + 31); const float sv = S[kb][e] - slope2 * (float)dist;
                    S[kb][e] = sv + __builtin_bit_cast(float, (dist >> 31) & NEGBITS); mx = fmaxf(mx, S[kb][e]); }
            }
        }
        mx = fmaxf(fmaxf(mx, __shfl_xor(mx, 32)), -1e20f);
        float l = 0.f;
#pragma unroll
        for (int kb = 0; kb < 4; ++kb) if (kb < nkb) {
#pragma unroll
            for (int e = 0; e < 16; ++e) { const float p = fexp2(S[kb][e] - mx); S[kb][e] = p; l += p; } }
        l += __shfl_xor(l, 32);
        const float inv = l > 0.f ? 1.f / l : 0.f;
        LAS float* imp = (LAS float*)(lds + A_IMP) + (hh * 64 + ql) * 33;
        float carry = 0.f;
#pragma unroll
        for (int kb = 0; kb < 4; ++kb) {
            if (kb < nkb) { S[kb] = S[kb] * inv;
#pragma unroll
                for (int ig = 0; ig < 4; ++ig) { const float gsum = (S[kb][4 * ig] + S[kb][4 * ig + 1]) + (S[kb][4 * ig + 2] + S[kb][4 * ig + 3]); const float plv = __shfl_xor(S[kb][4 * ig + 3], 32);
                    imp[8 * kb + 2 * ig + h] = gsum + (h ? plv : carry); carry = plv; } }
            else {
#pragma unroll
                for (int ig = 0; ig < 4; ++ig) { imp[8 * kb + 2 * ig + h] = (h == 0 && ig == 0) ? carry : 0.f; if (ig == 0) carry = 0.f; } } }
        f32x16 O[2];
#pragma unroll
        for (int dt = 0; dt < 2; ++dt)
#pragma unroll
            for (int e = 0; e < 16; ++e) O[dt][e] = 0.f;
#pragma unroll
        for (int kb = 0; kb < 4; ++kb) if (kb < nkb) {
#pragma unroll
            for (int s2 = 0; s2 < 2; ++s2) { const bf16x8 pb = pack8(S[kb], s2);
#pragma unroll
                for (int dt = 0; dt < 2; ++dt) { const LAS unsigned char* vp = lds + A_VC + (kb >> 1) * 8192 + ((kb & 1) * 32 + 16 * s2) * 128;
                    const s16x4 lo = __builtin_bit_cast(s16x4, __builtin_amdgcn_ds_read_tr16_b64_v4i16((LAS v4i16_t*)(vp + voff[dt][0])));
                    const s16x4 hi = __builtin_bit_cast(s16x4, __builtin_amdgcn_ds_read_tr16_b64_v4i16((LAS v4i16_t*)(vp + voff[dt][1])));
                    const bf16x8 vf = __builtin_shufflevector(lo, hi, 0, 1, 2, 3, 4, 5, 6, 7); O[dt] = MFMA32(vf, pb, O[dt]); } } }
        Oacc[0] = O[0] * g0; Oacc[1] = O[1] * g0;
    }
#define LBAR() do { asm volatile("s_waitcnt lgkmcnt(0)" ::: "memory"); __builtin_amdgcn_s_barrier(); } while (0)
    LBAR();
    if (has_nx) cmp_dma(lds, CMP, nxb, nxg, w, lane);
    {
        LAS float* IMP = (LAS float*)(lds + A_IMP); LAS float* TOT = (LAS float*)(lds + A_TOT); LAS unsigned* SEL = (LAS unsigned*)(lds + A_SEL);
        const int n = tid & 31;
#pragma unroll
        for (int ps = 0; ps < 4; ++ps) { const int q = ps * 16 + (tid >> 5);
            float v = (IMP[(0 * 64 + q) * 33 + n] + IMP[(1 * 64 + q) * 33 + n]) + (IMP[(2 * 64 + q) * 33 + n] + IMP[(3 * 64 + q) * 33 + n]);
            if (n == 0 || n == i || n == i - 1) v = 1e9f; else if (n > i) v = -1e30f;
            TOT[q * 32 + n] = v; }
        LBAR();
        unsigned uni = 0u;
#pragma unroll
        for (int ps = 0; ps < 4; ++ps) { const int q = ps * 16 + (tid >> 5); const float my = TOT[q * 32 + n]; int rank = 0;
#pragma unroll
            for (int j = 0; j < 8; ++j) { if (4 * j > i) break;
                const f32x4 t4 = *(const LAS f32x4*)(TOT + q * 32 + 4 * j);
#pragma unroll
                for (int e = 0; e < 4; ++e) { const int n2 = 4 * j + e; rank += (t4[e] > my || (t4[e] == my && n2 < n)) ? 1 : 0; } }
            const unsigned long long bal = __ballot(rank < 8);
            const unsigned lo = (unsigned)bal, hi = (unsigned)(bal >> 32);
            if (lane == 0) SEL[q] = lo; if (lane == 32) SEL[q] = hi;
            uni |= lo | hi; }
        const unsigned allowed = (i >= 31) ? 0xffffffffu : ((2u << i) - 1u);
        if (lane == 0) atomicOr((unsigned*)(SEL + 64), uni & allowed);
        LBAR();
    }
#undef LBAR
    const unsigned uni = __builtin_amdgcn_readfirstlane(((LAS unsigned*)(lds + A_SEL))[64]);
    const unsigned selm = ((LAS unsigned*)(lds + A_SEL))[ql];
    f32x16 AK;
#pragma unroll
    for (int e = 0; e < 16; ++e) AK[e] = slope2 * (float)crow(e, h);
    const int nlo = i - 4 < 0 ? 0 : i - 4;
    float mrun = -1e20f, lrun = 0.f; f32x16 O[2];
#pragma unroll
    for (int dt = 0; dt < 2; ++dt)
#pragma unroll
        for (int e = 0; e < 16; ++e) O[dt][e] = 0.f;
    const int qv = ql - 4 * h;
    int ck = 0, cn = i;
    int k1, n1; bool ok1 = true;
    if (cn > nlo) { k1 = 0; n1 = cn - 1; } else { k1 = 1; n1 = 31 - __builtin_clz(uni); }
    int k2 = k1, n2 = 0; bool ok2 = true;
#define TS_ADV(kk, nn, okk, ko, no, oko) do { ko = kk; no = 0; oko = okk; if (okk) { if (kk == 0) { if (nn > nlo) no = nn - 1; else { ko = 1; no = 31 - __builtin_clz(uni); } } \
        else { const unsigned rem_ = uni & ((1u << nn) - 1u); if (rem_ == 0u) oko = false; else no = 31 - __builtin_clz(rem_); } } } while (0)
    TS_ADV(k1, n1, ok1, k2, n2, ok2);
    int bc = 0;
    f32x16 Sa[2], Sb[2];
    asm volatile("s_waitcnt vmcnt(0)" ::: "memory"); __builtin_amdgcn_s_barrier();
    qk_tile(lds + A_KT, qf, AK, Sa, r, h);
#define TILE_STEP(SC, SN) { \
        asm volatile("s_waitcnt vmcnt(0)" ::: "memory");        \
        __builtin_amdgcn_s_barrier();                             \
        { const bool pf_ = ok1 && ok2; const int pk_ = pf_ ? k2 : ck, pn_ = pf_ ? n2 : cn; \
          int b2 = bc + 2; b2 = b2 >= 3 ? b2 - 3 : b2; \
          tile_dma(lds, b2, pk_ ? KS : KW, pk_ ? VS : VW, tbase + (size_t)(64 * pn_) * 256, w, lane); } \
        { const int b1 = bc + 1 >= 3 ? 0 : bc + 1; \
          sm_pv_tile(SC, lds + A_VT + bc * A_VT_SZ, O, mrun, lrun, ck, cn, i, tq, qv, slope2, selm, voff, ok1, lds + A_KT + b1 * A_KT_SZ, qf, AK, SN, r, h); } \
        if (!ok1 || k1 != ck) {       \
            const float lt = lrun + __shfl_xor(lrun, 32); const float sc = *(const LAS float*)(lds + A_GATE + tid * 8 + (ck ? 0 : 4)) * (lt > 0.f ? 1.f / lt : 0.f); \
            Oacc[0] = Oacc[0] + O[0] * sc; Oacc[1] = Oacc[1] + O[1] * sc; \
            mrun = -1e20f; lrun = 0.f; \
            _Pragma("unroll") for (int dt = 0; dt < 2; ++dt) _Pragma("unroll") for (int e = 0; e < 16; ++e) O[dt][e] = 0.f; \
        } \
        if (!ok1) break; \
        ck = k1; cn = n1; k1 = k2; n1 = n2; ok1 = ok2; { int k3, n3; bool ok3; TS_ADV(k2, n2, ok2, k3, n3, ok3); k2 = k3; n2 = n3; ok2 = ok3; } \
        bc = bc + 1 >= 3 ? 0 : bc + 1; }
    for (;;) {
        TILE_STEP(Sa, Sb)
        TILE_STEP(Sb, Sa)
    }
#undef TILE_STEP
#undef TS_ADV
    asm volatile("s_waitcnt vmcnt(0)" ::: "memory");
    __builtin_amdgcn_s_barrier();
    {
        LAS unsigned char* st = lds + (w < 5 ? w * 8704 : A_IMP + (w - 5) * 8704);
#pragma unroll
        for (int dt = 0; dt < 2; ++dt)
#pragma unroll
            for (int ig = 0; ig < 4; ++ig) { f32x4 v = {Oacc[dt][4 * ig], Oacc[dt][4 * ig + 1], Oacc[dt][4 * ig + 2], Oacc[dt][4 * ig + 3]};
                *(LAS f32x4*)(st + r * 272 + (32 * dt + 8 * ig + 4 * h) * 4) = v; }
        asm volatile("s_waitcnt lgkmcnt(0)" ::: "memory");
        const int qq = lane >> 3, dc = lane & 7;
#pragma unroll
        for (int j = 0; j < 4; ++j) { const int qr = 8 * j + qq;
            const size_t off = ((size_t)b * SEQ + 64 * i + 32 * qh + qr) * 1024 + head * 64 + dc * 8;
            const u32x4 z = *(const u32x4*)(SZN + off);
            const f32x4 o0 = *(const LAS f32x4*)(st + qr * 272 + dc * 32), o1 = *(const LAS f32x4*)(st + qr * 272 + dc * 32 + 16);
            u32x4 o; o.x = cvtpk(o0[0] * bf_lo(z.x), o0[1] * bf_hi(z.x)); o.y = cvtpk(o0[2] * bf_lo(z.y), o0[3] * bf_hi(z.y));
            o.z = cvtpk(o1[0] * bf_lo(z.z), o1[1] * bf_hi(z.z)); o.w = cvtpk(o1[2] * bf_lo(z.w), o1[3] * bf_hi(z.w));
            *(u32x4*)(AO + off) = o; }
    }
}

DI void phase_attn(const Args& a, LAS unsigned char* lds) {
    unsigned char* ws = a.ws; const int G = gridDim.x;
    const bf16_t* QB = (const bf16_t*)(ws + WS_QB); const bf16_t* KV = (const bf16_t*)(ws + WS_KV); const bf16_t* CMP = (const bf16_t*)(ws + WS_CMP);
    const bf16_t* SZN = (const bf16_t*)(ws + WS_SZN); const float* GT = (const float*)(ws + WS_GATE); bf16_t* AO = (bf16_t*)(ws + WS_XB);
    for (int k = 0;; ++k) {
        const long idx = (long)k * G + blockIdx.x; if (idx >= 2048) break;
        const int grp = (int)(idx >> 6), sub = (int)(idx & 63);
        const int per = G >> 6;
        int lvl = grp;
        if (per > 1 && (k & 1)) { const int base = (grp / per) * per; lvl = base + (per - 1 - (grp - base)); if (lvl > 31) lvl = grp; }
        const int i = 31 - lvl, b = sub >> 2, g = (sub + k) & 3;
        const long idx2 = (long)(k + 1) * G + blockIdx.x; const bool has_nx = idx2 < 2048; const int sub2 = (int)(idx2 & 63);
        attn_item(lds, QB, KV, CMP, SZN, GT, AO, b, i, g, k == 0, has_nx, sub2 >> 2, (sub2 + k + 1) & 3);
    }
}

constexpr int LDS_BYTES = 147456, LDS_CTL = 131072;
constexpr int N_PHASES = 12;
__global__ void __launch_bounds__(512, 2) fwd_kernel(Args a) {
    extern __shared__ __attribute__((aligned(16))) unsigned char lds_raw[];
    LAS unsigned char* lds = (LAS unsigned char*)lds_raw;
    unsigned char* ws = a.ws; const int G = gridDim.x, bid = blockIdx.x;
    const int lo = a.ph_lo, hi = a.ph_hi;
#define IN(k) (lo <= (k) && (k) < hi)
    if (threadIdx.x < 8) ((LAS unsigned*)(lds + LDS_CTL))[threadIdx.x] = 0u;
    __syncthreads();
    XcdBarrier bar = xcd_barrier_post((unsigned*)(ws + WS_CTL), (volatile LAS unsigned*)(lds + LDS_CTL));
#define SEAM(k) do { if (IN(k) && IN((k) + 1)) { if ((k) == 0) cg::this_grid().sync(); else xcd_barrier(bar); } } while (0)
    const char* XB = (const char*)(ws + WS_XB);
    const bool wc_private = G >= 64;
    if (IN(0)) {
        if (wc_private) { if (bid < 32) wc_unit(a, lds, bid); phase_convert(a, lds, 32, false); }
        else phase_convert(a, lds, 0, true);
        phase_pool(a, bid, G);
    }
    SEAM(0);
    if (IN(1) && !wc_private) {
        const pg8::Geom g{512, 512, 2048, 128, 128, 128 * 512 * 2, 128 * 2048 * 2};
        SchedWc S{G, bid, (const char*)(ws + WS_WGT), (const char*)(ws + WS_WINB)};
        EpiWc E{(bf16_t*)(ws + WS_WCT), a.in[I_PSCALE]};
        pg8::gemm_phase<EpiWc, SchedWc, false>(lds, g, S, E);
    }
    if (!wc_private) SEAM(1);
    if (IN(2)) { const float* part = (const float*)(ws + WS_PART); float* gb = (float*)(ws + WS_GB);
        for (int e = bid * 512 + (int)threadIdx.x; e < 2 * NSA_PAD; e += G * 512) { const int which = e / NSA_PAD, c = e - which * NSA_PAD; float t = 0.f;
#pragma unroll 8
            for (int ks = 0; ks < 32; ++ks) t += part[(size_t)(ks * 2 + which) * NSA_PAD + c];
            gb[e] = t; } }
    if (IN(2)) {
        const pg8::Geom g{1024, 1024, 1024, 128, 128, 128 * 1024 * 2, 128 * 1024 * 2};
        SchedZU S{G, bid, XB, (const char*)(ws + WS_XP), (const char*)(ws + WS_WZT), (const char*)(ws + WS_WCT)};
        EpiZU E{(bf16_t*)(ws + WS_A), (bf16_t*)a.out};
        pg8::gemm_phase<EpiZU, SchedZU, true>(lds, g, S, E);
    }
    SEAM(2);
    if (IN(4)) {
        const pg8::Geom g{2048, 2048, 2048, 128, 128, 128 * 2048 * 2, 128 * 2048 * 2};
        SchedPlain S{MTOK / 256, 4, G, bid, (const char*)(ws + WS_A), (const char*)(ws + WS_WPOT), (size_t)256 * 2048 * 2, (size_t)256 * 2048 * 2};
        EpiRes0 E{(float*)(ws + WS_V), (bf16_t*)(ws + WS_XB), a.in[I_X], (float*)(ws + WS_STATS)};
        pg8::gemm_phase<EpiRes0, SchedPlain, true>(lds, g, S, E);
    }
    SEAM(4);
    if (IN(5)) { const float* ST = (const float*)(ws + WS_STATS); float* SF = (float*)(ws + WS_SF);
        for (int row = bid * 512 + (int)threadIdx.x; row < MTOK; row += G * 512) { const f32x4* p = (const f32x4*)(ST + (size_t)row * 32); float s_ = 0.f, q_ = 0.f;
#pragma unroll
            for (int j = 0; j < 8; ++j) { const f32x4 t = p[j]; s_ += t[0] + t[2]; q_ += t[1] + t[3]; }
            const float mean = s_ * (1.f / DM), var = q_ * (1.f / DM) - mean * mean; f32x2 o = {mean, 1.f / sqrtf(var + LN_EPS)}; *(f32x2*)(SF + (size_t)row * 2) = o; } }
    SEAM(5);
    if (IN(6)) {
        const pg8::Geom g{1024, 1024, 1024, 128, 128, 128 * 1024 * 2, 128 * 1024 * 2};
        EpiNsaIn E{(bf16_t*)(ws + WS_QB), (bf16_t*)(ws + WS_KV), (bf16_t*)(ws + WS_SZN), (float*)(ws + WS_GATE), (const float*)(ws + WS_SF), (const float*)(ws + WS_GB)};
        if (G == 256) { SchedNsaA S{G, bid, XB, (const char*)(ws + WS_WNIT)}; pg8::gemm_phase<EpiNsaIn, SchedNsaA, true>(lds, g, S, E); }
        else { SchedPlain S{MTOK / 256, NSA_PAD / 256, G, bid, XB, (const char*)(ws + WS_WNIT), (size_t)256 * 1024 * 2, (size_t)256 * 1024 * 2}; pg8::gemm_phase<EpiNsaIn, SchedPlain, true>(lds, g, S, E); }
    }
    SEAM(6);
    if (IN(7) && G == 256) {
        const pg8::Geom g{1024, 1024, 1024, 128, 128, 128 * 1024 * 2, 128 * 1024 * 2};
        EpiNsaIn E{(bf16_t*)(ws + WS_QB), (bf16_t*)(ws + WS_KV), (bf16_t*)(ws + WS_SZN), (float*)(ws + WS_GATE), (const float*)(ws + WS_SF), (const float*)(ws + WS_GB)};
        SchedNsaB S{bid, XB, (const char*)(ws + WS_WNIT)}; pg8::gemm_phase<EpiNsaIn, SchedNsaB, true>(lds, g, S, E);
    }
    if (IN(7)) {
        const pg8::Geom g{2048, 4096, 2048, 512, 128, 128, 128 * 2048 * 2};
        SchedCmp1 S{G, bid, (const char*)(ws + WS_KV), (const char*)(ws + WS_W1T)};
        EpiHid E{(bf16_t*)(ws + WS_HID), (const float*)(ws + WS_BIAS)};
        pg8::gemm_phase<EpiHid, SchedCmp1, false>(lds, g, S, E);
        asm volatile("s_waitcnt vmcnt(0)" ::: "memory"); __syncthreads();
    }
    if (IN(8)) {
        const pg8::Geom g{256, 256, 256, 128, 128, 128 * 256 * 2, 128 * 256 * 2};
        SchedCmp2 S{G, bid, (const char*)(ws + WS_HID), (const char*)(ws + WS_W2T)};
        EpiCmp E{(bf16_t*)(ws + WS_CMP)};
        pg8::gemm_phase<EpiCmp, SchedCmp2, false>(lds, g, S, E);
    }
    SEAM(8);
    if (IN(9)) phase_attn(a, lds);
    SEAM(9);
    if (IN(10)) {
        const pg8::Geom g{1024, 1024, 1024, 128, 128, 128 * 1024 * 2, 128 * 1024 * 2};
        SchedPlain S{MTOK / 256, 4, G, bid, XB, (const char*)(ws + WS_WNOT), (size_t)256 * 1024 * 2, (size_t)256 * 1024 * 2};
        EpiBf16 E{(bf16_t*)(ws + WS_QB)};
        pg8::gemm_phase<EpiBf16, SchedPlain, true>(lds, g, S, E);
    }
    SEAM(10);
    if (IN(11)) phase_final((const float*)(ws + WS_V), (const float*)(ws + WS_SF), (const bf16_t*)(ws + WS_QB), a.out, a.in[I_LNG], a.in[I_LNB]);
#undef IN
#undef SEAM
}

extern "C" void kernel_launch(void* const* d_in, const int* in_sizes, int n_in, void* d_out, int out_size, void* d_ws, size_t ws_size, hipStream_t stream) {
    static int grid = 0;
    if (grid == 0) {
        if (n_in != 15 || out_size != MTOK * DM || ws_size < WS_END) { fprintf(stderr, "kernel_launch: unexpected problem shape (n_in %d, out %d, ws %zu)\n", n_in, out_size, ws_size); grid = -1; return; }
        int dev = 0, cus = 0, per_cu = 0;
        if (hipGetDevice(&dev) != hipSuccess || hipDeviceGetAttribute(&cus, hipDeviceAttributeMultiprocessorCount, dev) != hipSuccess) { grid = -1; return; }
        if (hipFuncSetAttribute((const void*)fwd_kernel, hipFuncAttributeMaxDynamicSharedMemorySize, LDS_BYTES) != hipSuccess) { fprintf(stderr, "kernel_launch: hipFuncSetAttribute failed\n"); grid = -1; return; }
        if (hipOccupancyMaxActiveBlocksPerMultiprocessor(&per_cu, (const void*)fwd_kernel, 512, LDS_BYTES) != hipSuccess || per_cu < 1) per_cu = 1;
        (void)hipGetLastError();
        grid = cus * per_cu;
    }
    if (grid < 0) return;
    if (hipMemsetAsync((char*)d_ws + WS_CTL, 0, 16384, stream) != hipSuccess) { fprintf(stderr, "kernel_launch: memset failed\n"); return; }
    Args a{};
    for (int i = 0; i < 15; ++i) a.in[i] = (const float*)d_in[i];
    a.out = (float*)d_out; a.ws = (unsigned char*)d_ws;
#if MK_SINGLE
    a.ph_lo = 0; a.ph_hi = N_PHASES;
    void* args[] = {&a};
    hipError_t e = hipLaunchCooperativeKernel((const void*)fwd_kernel, dim3(grid), dim3(512), args, LDS_BYTES, stream);
    if (e != hipSuccess) fprintf(stderr, "cooperative launch failed: %s (grid %d)\n", hipGetErrorString(e), grid);
#else
    for (int p = 0; p < N_PHASES; ++p) { a.ph_lo = p; a.ph_hi = p + 1;
        const int reps = ((REP_MASK >> p) & 1) ? 2 : 1;
        for (int r = 0; r < reps; ++r) hipLaunchKernelGGL(fwd_kernel, dim3(grid), dim3(512), LDS_BYTES, stream, a); }
#endif
}
```

```cpp
#include <hip/hip_runtime.h>
#include <hip/hip_cooperative_groups.h>
#include <cstdio>
#include <cstdint>
namespace cg = cooperative_groups;

#ifndef REP_MASK
#define REP_MASK 0
#endif
#ifndef MK_SINGLE
#define MK_SINGLE 1
#endif

#define LAS __attribute__((address_space(3)))
#define DI __device__ __forceinline__
typedef unsigned short bf16_t;
typedef short bf16x8 __attribute__((ext_vector_type(8)));
typedef short s16x4 __attribute__((ext_vector_type(4)));
typedef float f32x2 __attribute__((ext_vector_type(2)));
typedef float f32x4 __attribute__((ext_vector_type(4)));
typedef float f32x16 __attribute__((ext_vector_type(16)));
typedef unsigned u32x2 __attribute__((ext_vector_type(2)));
typedef unsigned u32x4 __attribute__((ext_vector_type(4)));
typedef __bf16 bf16x2_t __attribute__((ext_vector_type(2)));

constexpr int SEQ = 2048, NB = 16, DM = 1024, MTOK = NB * SEQ;
constexpr int DPOOL = 2048, NSA_IN = 3632, NSA_PAD = 3840;
constexpr int NCMP_PAD = 128;
constexpr float DN_ALPHA = 1.41421356237309515f;
constexpr float LN_EPS = 1e-5f;
constexpr float LOG2E = 1.4426950408889634f;

constexpr size_t MiB = 1u << 20;
constexpr size_t WS_CTL  = 0;
constexpr size_t WS_WINB = 1 * MiB;
constexpr size_t WS_WZT  = 5 * MiB;
constexpr size_t WS_WGT  = 9 * MiB;
constexpr size_t WS_WCT  = 11 * MiB;
constexpr size_t WS_WPOT = 15 * MiB;
constexpr size_t WS_WNIT = 19 * MiB;
constexpr size_t WS_W1T  = 27 * MiB;
constexpr size_t WS_W2T  = 29 * MiB;
constexpr size_t WS_WNOT = 30 * MiB;
constexpr size_t WS_BIAS = 32 * MiB;
constexpr size_t WS_STATS = 34 * MiB;
constexpr size_t WS_GB   = 33 * MiB;
constexpr size_t WS_SF   = 39 * MiB;
constexpr size_t WS_PART = 38 * MiB;
constexpr size_t WS_XB   = 40 * MiB;
constexpr size_t WS_XP   = 104 * MiB;
constexpr size_t WS_V    = 104 * MiB;
constexpr size_t WS_A    = 360 * MiB;
constexpr size_t WS_QB   = 232 * MiB;
constexpr size_t WS_SZN  = 296 * MiB;
constexpr size_t WS_KV   = 360 * MiB;
constexpr size_t WS_GATE = 456 * MiB;
constexpr size_t WS_HID  = 462 * MiB;
constexpr size_t WS_CMP  = 470 * MiB;
constexpr size_t WS_END  = 472 * MiB;

DI unsigned cvtpk(float lo, float hi) { f32x2 v = {lo, hi}; bf16x2_t b = __builtin_convertvector(v, bf16x2_t); return __builtin_bit_cast(unsigned, b); }
DI float bf_lo(unsigned u) { return __builtin_bit_cast(float, u << 16); }
DI float bf_hi(unsigned u) { return __builtin_bit_cast(float, u & 0xffff0000u); }
DI float fexp2(float x) { return __builtin_amdgcn_exp2f(x); }
DI float sigmoid_f(float v) { return __builtin_amdgcn_rcpf(1.f + fexp2(-v * LOG2E)); }
DI float silu_f(float v) { return v * sigmoid_f(v); }
DI float wave_sum(float v) {
#pragma unroll
    for (int o = 1; o < 64; o <<= 1) v += __shfl_xor(v, o);
    return v;
}
#define MFMA32(a, b, c) __builtin_amdgcn_mfma_f32_32x32x16_bf16((a), (b), (c), 0, 0, 0)

namespace pg8 {
constexpr int BM = 256, BK = 64, HALF = 128, HTB = HALF * BK * 2, STAGE_BYTES = 8 * HTB, NXCD = 8, WGM = 8;
DI int lds_byte(int r, int c) { const int st = (r >> 4) * 2 + (c >> 5), rr = r & 15, cc = c & 31, ob = rr * 64 + cc * 2; return st * 1024 + (ob ^ (((ob >> 9) & 1) << 5)); }
DI void stage_rc(int b, int& R, int& C) { const int st = b / 1024, sb = b % 1024, swz = sb ^ (((sb >> 9) & 1) << 5); R = (st >> 1) * 16 + swz / 64; C = (st & 1) * 32 + (swz % 64) / 2; }
DI int perm32(int rho) { const int n = rho >> 4, i = rho & 15; return 8 * (i >> 2) + 4 * n + (i & 3); }

struct Unit { const char* a; const char* b; int pm, pn; };
struct Geom { int K; unsigned lda, ldb; unsigned kstepA, kstepB; unsigned hstepA, hstepB; };

DI bool order_next(int nM, int nN, int G, int c, int i, int& pm, int& pn) {
    const int nwg = nM * nN; const long L = (long)i * G + c; if (L >= nwg) return false;
    int wgid = (int)L; { const int q = nwg / NXCD, r = nwg % NXCD, xcd = wgid % NXCD, off = wgid / NXCD; wgid = (xcd < r ? xcd * (q + 1) : r * (q + 1) + (xcd - r) * q) + off; }
    const int nig = WGM * nN, gid = wgid / nig, fm = gid * WGM, gsz = (nM - fm) < WGM ? (nM - fm) : WGM;
    pm = fm + ((wgid % nig) % gsz); pn = (wgid % nig) / gsz; return true;
}

DI void order_map(int nM, int nN, int L, int& pm, int& pn) {
    const int nwg = nM * nN; int wgid = L; { const int q = nwg / NXCD, r = nwg % NXCD, xcd = wgid % NXCD, off = wgid / NXCD; wgid = (xcd < r ? xcd * (q + 1) : r * (q + 1) + (xcd - r) * q) + off; }
    const int nig = WGM * nN, gid = wgid / nig, fm = gid * WGM, gsz = (nM - fm) < WGM ? (nM - fm) : WGM;
    pm = fm + ((wgid % nig) % gsz); pn = (wgid % nig) / gsz;
}
template <class Epi, class Sched, bool ALIGN_EPI>
DI void gemm_phase(LAS unsigned char* lds, const Geom g, const Sched& S, const Epi& E) {
    const int tid = threadIdx.x, wid = __builtin_amdgcn_readfirstlane(tid >> 6), lane = tid & 63, wr = wid >> 2, wc = wid & 3, fr = lane & 15, fq = lane >> 4;
    const int nt = g.K / BK;
    unsigned voffA[2], voffB[2];
#pragma unroll
    for (int i = 0; i < 2; ++i) { int R, C; stage_rc(tid * 16 + i * 8192, R, C); const int Rb = (R & ~31) + perm32(R & 31);
        voffA[i] = (unsigned)(R * g.lda + C) * 2u; voffB[i] = (unsigned)(Rb * g.ldb + C) * 2u; }
    const size_t kA = g.kstepA, kB = g.kstepB, hA = g.hstepA, hB = g.hstepB;
    const unsigned ldsw = (unsigned)wid * 1024u;
    const int aoff = lds_byte(wr * 64 + fr, fq * 8), boff = lds_byte(wc * 32 + fr, fq * 8);
#define PG8_SA(b, h) (((b) * 2 + (h)) * HTB)
#define PG8_SB(b, h) ((4 + (b) * 2 + (h)) * HTB)
#define PG8_STAGE(bufoff, gbase, voff) do { _Pragma("unroll") for (int _i = 0; _i < 2; ++_i) \
        __builtin_amdgcn_global_load_lds((const unsigned*)((const char*)(gbase) + (voff)[_i]), (LAS unsigned*)(lds + (bufoff) + ldsw + _i * 8192), 16, 0, 0); } while (0)
#define PG8_LDA(dst, b, h) do { _Pragma("unroll") for (int m = 0; m < 4; ++m) _Pragma("unroll") for (int k = 0; k < 2; ++k) dst[m][k] = *(const LAS bf16x8*)(lds + PG8_SA(b, h) + aoff + m * 2048 + k * 1024); } while (0)
#define PG8_LDB(dst, b, h) do { _Pragma("unroll") for (int n = 0; n < 2; ++n) _Pragma("unroll") for (int k = 0; k < 2; ++k) dst[n][k] = *(const LAS bf16x8*)(lds + PG8_SB(b, h) + boff + n * 2048 + k * 1024); } while (0)
#define PG8_MMA(ai, bj, At, Bt) do { __builtin_amdgcn_s_setprio(1); _Pragma("unroll") for (int m = 0; m < 4; ++m) _Pragma("unroll") for (int n = 0; n < 2; ++n) _Pragma("unroll") for (int k = 0; k < 2; ++k) \
        acc[ai][bj][m][n] = __builtin_amdgcn_mfma_f32_16x16x32_bf16(Bt[n][k], At[m][k], acc[ai][bj][m][n], 0, 0, 0); __builtin_amdgcn_s_setprio(0); } while (0)
#define PG8_WAIT_V(n) asm volatile("s_waitcnt vmcnt(" #n ")" ::: "memory")
#define PG8_WAIT_L(n) asm volatile("s_waitcnt lgkmcnt(" #n ")" ::: "memory")
#define PG8_BAR __builtin_amdgcn_s_barrier()
#define PG8_SCHED __builtin_amdgcn_sched_barrier(0)
    Unit cur, nxt; int ui = 0;
    if (!S.next(0, cur)) return;
    f32x4 acc[2][2][4][2];
#pragma unroll
    for (int a = 0; a < 2; ++a)
#pragma unroll
        for (int b = 0; b < 2; ++b)
#pragma unroll
            for (int m = 0; m < 4; ++m)
#pragma unroll
                for (int n = 0; n < 2; ++n) acc[a][b][m][n] = (f32x4){0.f, 0.f, 0.f, 0.f};
    bf16x8 At[4][2], B0[2][2], B1[2][2];
    const char* cA = cur.a; const char* cB = cur.b;
    PG8_STAGE(PG8_SB(0, 0), cB, voffB); PG8_STAGE(PG8_SB(0, 1), cB + hB, voffB); PG8_STAGE(PG8_SA(0, 0), cA, voffA); PG8_STAGE(PG8_SA(0, 1), cA + hA, voffA);
    if (wr == 1) PG8_BAR;
    PG8_WAIT_V(2); PG8_BAR;
    PG8_STAGE(PG8_SB(1, 0), cB + kB, voffB); PG8_STAGE(PG8_SA(1, 0), cA + kA, voffA); PG8_STAGE(PG8_SB(1, 1), cB + hB + kB, voffB);
    PG8_WAIT_V(6); PG8_BAR;
    for (;;) {
        const bool has_next = S.next(ui + 1, nxt);
        const char* nA = has_next ? nxt.a : cA; const char* nB = has_next ? nxt.b : cB;
        for (int t = 0; t < nt; t += 2) {
            const bool last = (t == nt - 2);
            const char* a1 = cA + (size_t)(t + 1) * kA;
            const char* a2 = last ? nA : cA + (size_t)(t + 2) * kA; const char* b2 = last ? nB : cB + (size_t)(t + 2) * kB;
            const char* a3 = a2 + kA; const char* b3 = b2 + kB;
            PG8_LDB(B0, 0, 0); PG8_LDB(B1, 0, 1); PG8_SCHED; PG8_LDA(At, 0, 0); PG8_STAGE(PG8_SA(1, 1), a1 + hA, voffA);
            PG8_WAIT_V(8); PG8_WAIT_L(0); PG8_BAR; PG8_MMA(0, 0, At, B0); PG8_MMA(0, 1, At, B1); PG8_BAR; PG8_SCHED;
            PG8_LDA(At, 0, 1); PG8_STAGE(PG8_SB(0, 0), b2, voffB); PG8_STAGE(PG8_SB(0, 1), b2 + hB, voffB); PG8_STAGE(PG8_SA(0, 0), a2, voffA);
            PG8_WAIT_V(8); PG8_WAIT_L(0); PG8_BAR; PG8_MMA(1, 0, At, B0); PG8_MMA(1, 1, At, B1); PG8_BAR; PG8_SCHED;
            PG8_LDB(B0, 1, 0); PG8_LDB(B1, 1, 1); PG8_SCHED; PG8_LDA(At, 1, 0); PG8_STAGE(PG8_SA(0, 1), a2 + hA, voffA);
            PG8_WAIT_V(8); PG8_WAIT_L(0); PG8_BAR; PG8_MMA(0, 0, At, B0); PG8_MMA(0, 1, At, B1); PG8_BAR; PG8_SCHED;
            PG8_LDA(At, 1, 1); PG8_STAGE(PG8_SB(1, 0), b3, voffB); PG8_STAGE(PG8_SB(1, 1), b3 + hB, voffB); PG8_STAGE(PG8_SA(1, 0), a3, voffA);
            PG8_WAIT_V(8); PG8_WAIT_L(0); PG8_BAR; PG8_MMA(1, 0, At, B0); PG8_MMA(1, 1, At, B1); PG8_BAR; PG8_SCHED;
        }
        if constexpr (ALIGN_EPI) { if (wr == 0) PG8_BAR; }
        E(acc, cur, wr, wc, fr, fq);
        if (!has_next) break;
#pragma unroll
        for (int a = 0; a < 2; ++a)
#pragma unroll
            for (int b = 0; b < 2; ++b)
#pragma unroll
                for (int m = 0; m < 4; ++m)
#pragma unroll
                    for (int n = 0; n < 2; ++n) acc[a][b][m][n] = (f32x4){0.f, 0.f, 0.f, 0.f};
        cur = nxt; cA = nA; cB = nB; ++ui;
        if constexpr (ALIGN_EPI) { if (wr == 1) PG8_BAR; }
    }
    PG8_WAIT_V(0);
    if constexpr (!ALIGN_EPI) { if (wr == 0) PG8_BAR; }
    PG8_BAR;
#undef PG8_SA
#undef PG8_SB
#undef PG8_STAGE
#undef PG8_LDA
#undef PG8_LDB
#undef PG8_MMA
#undef PG8_WAIT_V
#undef PG8_WAIT_L
#undef PG8_BAR
#undef PG8_SCHED
}
}
using pg8::Unit;
typedef f32x4 Acc[2][2][4][2];

DI void st8_bf16(bf16_t* p, f32x4 v0, f32x4 v1) { u32x4 w; w.x = cvtpk(v0[0], v0[1]); w.y = cvtpk(v0[2], v0[3]); w.z = cvtpk(v1[0], v1[1]); w.w = cvtpk(v1[2], v1[3]); *(u32x4*)p = w; }

struct SchedPlain {
    int nM, nN, G, c; const char* A; const char* B; size_t atile, btile;
    DI bool next(int i, Unit& u) const { int pm, pn; if (!pg8::order_next(nM, nN, G, c, i, pm, pn)) return false; u.pm = pm; u.pn = pn; u.a = A + (size_t)pm * atile; u.b = B + (size_t)pn * btile; return true; }
};
struct SchedU {
    int nM, nN, G, c; const char* A; const char* B; size_t atile, btile, agroup;
    DI bool next(int i, Unit& u) const { int pm, pn; if (!pg8::order_next(nM, nN, G, c, i, pm, pn)) return false; u.pm = pm; u.pn = pn; u.a = A + (size_t)(pn >> 1) * agroup + (size_t)pm * atile; u.b = B + (size_t)pn * btile; return true; }
};
struct SchedNsaA {
    int G, c; const char* A; const char* B;
    DI bool next(int i, Unit& u) const { int pm, pn; if (!pg8::order_next(MTOK / 256, 2, G, c, i, pm, pn)) return false; u.pm = pm; u.pn = pn + 4; u.a = A + (size_t)pm * (256 * 1024 * 2); u.b = B + (size_t)(pn + 4) * (256 * 1024 * 2); return true; }
};
struct SchedNsaB {
    int c; const char* A; const char* B;
    DI bool next(int i, Unit& u) const {
        int L;
        if (c < 64) { if (i >= 5) return false; L = i * 256 + c; }
        else if (c < 192) { if (i < 6) L = i * 256 + c; else if (i == 6) L = 1536 + (c - 64); else return false; }
        else { if (i < 6) L = i * 256 + c; else if (i == 6) L = 1280 + (c - 192); else return false; }
        int pm, pn; pg8::order_map(MTOK / 256, 13, L, pm, pn); pn = pn < 4 ? pn : pn + 2;
        u.pm = pm; u.pn = pn; u.a = A + (size_t)pm * (256 * 1024 * 2); u.b = B + (size_t)pn * (256 * 1024 * 2); return true; }
};
struct SchedZU {
    int G, c; const char* XBp; const char* XPp; const char* WZ; const char* WC;
    DI bool next(int i, Unit& u) const { int pm, pn; if (!pg8::order_next(MTOK / 256, 8, G, c, i >> 1, pm, pn)) return false; u.pm = pm;
        if ((i & 1) == 0) { u.pn = pn + 8; u.a = XBp + (size_t)pm * (256 * 1024 * 2); u.b = WZ + (size_t)pn * (256 * 1024 * 2); }
        else { u.pn = pn; u.a = XPp + (size_t)(pn >> 1) * ((size_t)MTOK * 1024 * 2) + (size_t)pm * (256 * 1024 * 2); u.b = WC + (size_t)pn * (256 * 1024 * 2); }
        return true; }
};
struct SchedWc {
    int G, c; const char* A; const char* B;
    DI bool next(int i, Unit& u) const { int pm, pn; if (!pg8::order_next(8, 4, G, c, i, pm, pn)) return false; u.pm = pm; u.pn = pn; u.a = A + (size_t)pm * (256 * 512 * 2); u.b = B + (size_t)pn * (256 * 2048 * 2) + (size_t)(pm >> 1) * 1024; return true; }
};
struct SchedCmp1 {
    int G, c; const char* KV; const char* W1;
    DI bool next(int i, Unit& u) const { int pm, pn; if (!pg8::order_next(64, 1, G, c, i, pm, pn)) return false; u.pm = pm; u.pn = 0;
        const int kv = pm >> 5, rt = pm & 31, b = rt >> 1, g0 = (rt & 1) * 2;
        u.a = KV + (size_t)kv * ((size_t)MTOK * 256 * 2) + ((size_t)b * SEQ * 256 + g0 * 64) * 2; u.b = W1 + (size_t)kv * (256 * 2048 * 2); return true; }
};
struct SchedCmp2 {
    int G, c; const char* H; const char* W2;
    DI bool next(int i, Unit& u) const { int pm, pn; if (!pg8::order_next(64, 1, G, c, i, pm, pn)) return false; u.pm = pm; u.pn = 0;
        u.a = H + (size_t)pm * (256 * 256 * 2); u.b = W2 + (size_t)(pm >> 5) * (256 * 256 * 2); return true; }
};

#define EPI_LOOP_ROWS for (int ai = 0; ai < 2; ++ai) for (int m = 0; m < 4; ++m)
struct EpiSilu {
    bf16_t* O; int ld;
    DI void operator()(const Acc& acc, const Unit& u, int wr, int wc, int fr, int fq) const {
        const int row0 = u.pm * 256 + wr * 64 + fr, col0 = u.pn * 256 + wc * 32 + 8 * fq;
#pragma unroll
        EPI_LOOP_ROWS { bf16_t* rp = O + (size_t)(row0 + ai * 128 + m * 16) * ld + col0;
#pragma unroll
            for (int bj = 0; bj < 2; ++bj) { f32x4 v0 = acc[ai][bj][m][0], v1 = acc[ai][bj][m][1];
#pragma unroll
                for (int e = 0; e < 4; ++e) { v0[e] = silu_f(v0[e]); v1[e] = silu_f(v1[e]); }
                st8_bf16(rp + bj * 128, v0, v1); } }
    }
};
struct EpiMulSz {
    bf16_t* O; const bf16_t* SZ; int ld;
    DI void operator()(const Acc& acc, const Unit& u, int wr, int wc, int fr, int fq) const {
        const int row0 = u.pm * 256 + wr * 64 + fr, col0 = u.pn * 256 + wc * 32 + 8 * fq;
#pragma unroll
        EPI_LOOP_ROWS { const size_t off = (size_t)(row0 + ai * 128 + m * 16) * ld + col0;
#pragma unroll
            for (int bj = 0; bj < 2; ++bj) { f32x4 v0 = acc[ai][bj][m][0], v1 = acc[ai][bj][m][1]; const u32x4 s = *(const u32x4*)(SZ + off + bj * 128);
                v0[0] *= bf_lo(s.x); v0[1] *= bf_hi(s.x); v0[2] *= bf_lo(s.y); v0[3] *= bf_hi(s.y); v1[0] *= bf_lo(s.z); v1[1] *= bf_hi(s.z); v1[2] *= bf_lo(s.w); v1[3] *= bf_hi(s.w);
                st8_bf16(O + off + bj * 128, v0, v1); } }
    }
};
DI void row_stats(const float* SF, int row, float& mean, float& rstd) { const f32x2 t = *(const f32x2*)(SF + (size_t)row * 2); mean = t[0]; rstd = t[1]; }
struct EpiZU {
    bf16_t* O; bf16_t* SZ;
    DI void operator()(const Acc& acc, const Unit& u, int wr, int wc, int fr, int fq) const {
        const bool isz = u.pn >= 8; const int rl0 = wr * 64 + fr, cl0 = wc * 32 + 8 * fq;
        if (isz) {
#pragma unroll
            EPI_LOOP_ROWS { bf16_t* rp = SZ + (size_t)(rl0 + ai * 128 + m * 16) * 256 + cl0;
#pragma unroll
                for (int bj = 0; bj < 2; ++bj) { f32x4 v0 = acc[ai][bj][m][0], v1 = acc[ai][bj][m][1];
#pragma unroll
                    for (int e = 0; e < 4; ++e) { v0[e] = silu_f(v0[e]); v1[e] = silu_f(v1[e]); }
                    st8_bf16(rp + bj * 128, v0, v1); } }
        } else {
            const int row0 = u.pm * 256 + rl0, col0 = u.pn * 256 + cl0;
            u32x4 zz[2][4][2];
#pragma unroll
            EPI_LOOP_ROWS {
#pragma unroll
                for (int bj = 0; bj < 2; ++bj) zz[ai][m][bj] = *(const u32x4*)(SZ + (size_t)(rl0 + ai * 128 + m * 16) * 256 + cl0 + bj * 128); }
            __builtin_amdgcn_sched_barrier(0);
#pragma unroll
            EPI_LOOP_ROWS { const size_t off = (size_t)(row0 + ai * 128 + m * 16) * 2048 + col0;
#pragma unroll
                for (int bj = 0; bj < 2; ++bj) { f32x4 v0 = acc[ai][bj][m][0], v1 = acc[ai][bj][m][1]; const u32x4 z = zz[ai][m][bj];
                    v0[0] *= bf_lo(z.x); v0[1] *= bf_hi(z.x); v0[2] *= bf_lo(z.y); v0[3] *= bf_hi(z.y); v1[0] *= bf_lo(z.z); v1[1] *= bf_hi(z.z); v1[2] *= bf_lo(z.w); v1[3] *= bf_hi(z.w);
                    st8_bf16(O + off + bj * 128, v0, v1); } }
        }
    }
};
struct EpiRes0 {
    float* O; bf16_t* OB; const float* R; float* ST;
    DI void operator()(const Acc& acc, const Unit& u, int wr, int wc, int fr, int fq) const {
        const int row0 = u.pm * 256 + wr * 64 + fr, col0 = u.pn * 256 + wc * 32 + 8 * fq;
#pragma unroll
        for (int ai = 0; ai < 2; ++ai) {
            f32x4 xr[4][2][2];
#pragma unroll
            for (int m = 0; m < 4; ++m)
#pragma unroll
                for (int bj = 0; bj < 2; ++bj) { const float* rp = R + (size_t)(row0 + ai * 128 + m * 16) * DM + col0 + bj * 128;
                    xr[m][bj][0] = __builtin_nontemporal_load((const f32x4*)rp); xr[m][bj][1] = __builtin_nontemporal_load((const f32x4*)(rp + 4)); }
            __builtin_amdgcn_sched_barrier(0);
#pragma unroll
            for (int m = 0; m < 4; ++m) { const int row = row0 + ai * 128 + m * 16; const size_t off = (size_t)row * DM + col0; float s = 0.f, q = 0.f;
#pragma unroll
                for (int bj = 0; bj < 2; ++bj) {
                    const f32x4 v0 = xr[m][bj][0] * DN_ALPHA + acc[ai][bj][m][0], v1 = xr[m][bj][1] * DN_ALPHA + acc[ai][bj][m][1];
                    __builtin_nontemporal_store(v0, (f32x4*)(O + off + bj * 128)); __builtin_nontemporal_store(v1, (f32x4*)(O + off + bj * 128 + 4)); st8_bf16(OB + off + bj * 128, v0, v1);
                    s += ((v0[0] + v0[1]) + (v0[2] + v0[3])) + ((v1[0] + v1[1]) + (v1[2] + v1[3]));
                    q += ((v0[0] * v0[0] + v0[1] * v0[1]) + (v0[2] * v0[2] + v0[3] * v0[3])) + ((v1[0] * v1[0] + v1[1] * v1[1]) + (v1[2] * v1[2] + v1[3] * v1[3])); }
                s += __shfl_xor(s, 16); q += __shfl_xor(q, 16); s += __shfl_xor(s, 32); q += __shfl_xor(q, 32);
                if (fq == 0) { f32x2 o = {s, q}; *(f32x2*)(ST + (size_t)row * 32 + (u.pn * 4 + wc) * 2) = o; } }
        }
    }
};
struct EpiBf16 {
    bf16_t* O;
    DI void operator()(const Acc& acc, const Unit& u, int wr, int wc, int fr, int fq) const {
        const int row0 = u.pm * 256 + wr * 64 + fr, col0 = u.pn * 256 + wc * 32 + 8 * fq;
#pragma unroll
        EPI_LOOP_ROWS { bf16_t* rp = O + (size_t)(row0 + ai * 128 + m * 16) * DM + col0;
#pragma unroll
            for (int bj = 0; bj < 2; ++bj) st8_bf16(rp + bj * 128, acc[ai][bj][m][0], acc[ai][bj][m][1]); }
    }
};
struct EpiRes1 {
    float* O; const float* V; const float* SF; const float* gam; const float* bet;
    DI void operator()(const Acc& acc, const Unit& u, int wr, int wc, int fr, int fq) const {
        const int row0 = u.pm * 256 + wr * 64 + fr, col0 = u.pn * 256 + wc * 32 + 8 * fq;
        f32x4 g[2][2], bt[2][2];
#pragma unroll
        for (int bj = 0; bj < 2; ++bj) { const int c = col0 + bj * 128; g[bj][0] = *(const f32x4*)(gam + c); g[bj][1] = *(const f32x4*)(gam + c + 4); bt[bj][0] = *(const f32x4*)(bet + c); bt[bj][1] = *(const f32x4*)(bet + c + 4); }
#pragma unroll
        EPI_LOOP_ROWS { const int row = row0 + ai * 128 + m * 16; float mean, rstd; row_stats(SF, row, mean, rstd);
#pragma unroll
            for (int bj = 0; bj < 2; ++bj) { const size_t off = (size_t)row * DM + col0 + bj * 128;
                const f32x4 r0 = *(const f32x4*)(V + off), r1 = *(const f32x4*)(V + off + 4);
                const f32x4 x0 = (r0 - mean) * rstd * g[bj][0] + bt[bj][0], x1 = (r1 - mean) * rstd * g[bj][1] + bt[bj][1];
                *(f32x4*)(O + off) = x0 * DN_ALPHA + acc[ai][bj][m][0]; *(f32x4*)(O + off + 4) = x1 * DN_ALPHA + acc[ai][bj][m][1]; } }
    }
};
struct EpiWc {
    bf16_t* O; const float* scale;
    DI void operator()(const Acc& acc, const Unit& u, int wr, int wc, int fr, int fq) const {
        const int row0 = u.pm * 256 + wr * 64 + fr, col0 = u.pn * 256 + wc * 32 + 8 * fq;
#pragma unroll
        EPI_LOOP_ROWS { const int row = row0 + ai * 128 + m * 16; const float sc = scale[row];
#pragma unroll
            for (int bj = 0; bj < 2; ++bj) st8_bf16(O + (size_t)row * 1024 + col0 + bj * 128, acc[ai][bj][m][0] * sc, acc[ai][bj][m][1] * sc); }
    }
};
struct EpiNsaIn {
    bf16_t* Q; bf16_t* KV; bf16_t* SZ; float* GT; const float* SF; const float* GB;
    DI void operator()(const Acc& acc, const Unit& u, int wr, int wc, int fr, int fq) const {
        const int row0 = u.pm * 256 + wr * 64 + fr, cl0 = wc * 32 + 8 * fq, pn = u.pn;
        if (pn == 14 && cl0 >= 48) return;
        f32x4 Gv[2][2], Bv[2][2];
#pragma unroll
        for (int bj = 0; bj < 2; ++bj) { const int c = pn * 256 + bj * 128 + cl0; Gv[bj][0] = *(const f32x4*)(GB + c); Gv[bj][1] = *(const f32x4*)(GB + c + 4); Bv[bj][0] = *(const f32x4*)(GB + NSA_PAD + c); Bv[bj][1] = *(const f32x4*)(GB + NSA_PAD + c + 4); }
        f32x2 stt[2][4];
#pragma unroll
        EPI_LOOP_ROWS stt[ai][m] = *(const f32x2*)(SF + (size_t)(row0 + ai * 128 + m * 16) * 2);
        __builtin_amdgcn_sched_barrier(0);
#pragma unroll
        EPI_LOOP_ROWS { const int row = row0 + ai * 128 + m * 16; const float mean = stt[ai][m][0], rstd = stt[ai][m][1];
#pragma unroll
            for (int bj = 0; bj < 2; ++bj) {
                if (pn == 14 && bj == 1) break;
                f32x4 v0 = (acc[ai][bj][m][0] - Gv[bj][0] * mean) * rstd + Bv[bj][0], v1 = (acc[ai][bj][m][1] - Gv[bj][1] * mean) * rstd + Bv[bj][1];
                if (pn < 4) { v0 = v0 * (0.125f * LOG2E); v1 = v1 * (0.125f * LOG2E); st8_bf16(Q + (size_t)row * 1024 + pn * 256 + bj * 128 + cl0, v0, v1); }
                else if (pn < 10) { st8_bf16(KV + (size_t)(pn - 4) * ((size_t)MTOK * 256) + (size_t)row * 256 + bj * 128 + cl0, v0, v1); }
                else if (pn < 14) {
#pragma unroll
                    for (int e = 0; e < 4; ++e) { v0[e] = silu_f(v0[e]); v1[e] = silu_f(v1[e]); }
                    st8_bf16(SZ + (size_t)row * 1024 + (pn - 10) * 256 + bj * 128 + cl0, v0, v1); }
                else {
#pragma unroll
                    for (int e = 0; e < 4; ++e) { v0[e] = sigmoid_f(v0[e]); v1[e] = sigmoid_f(v1[e]); }
                    float* rp = GT + (size_t)row * 48 + cl0; *(f32x4*)rp = v0; *(f32x4*)(rp + 4) = v1; } } }
    }
};
struct EpiHid {
    bf16_t* O; const float* bias;
    DI void operator()(const Acc& acc, const Unit& u, int wr, int wc, int fr, int fq) const {
        const int row0 = u.pm * 256 + wr * 64 + fr, col0 = wc * 32 + 8 * fq; const float* bp = bias + (u.pm >> 5) * 256 + col0;
#pragma unroll
        for (int bj = 0; bj < 2; ++bj) { const f32x4 b0 = *(const f32x4*)(bp + bj * 128), b1 = *(const f32x4*)(bp + bj * 128 + 4);
#pragma unroll
            EPI_LOOP_ROWS { f32x4 v0 = acc[ai][bj][m][0] + b0, v1 = acc[ai][bj][m][1] + b1;
#pragma unroll
                for (int e = 0; e < 4; ++e) { v0[e] = silu_f(v0[e]); v1[e] = silu_f(v1[e]); }
                st8_bf16(O + (size_t)(row0 + ai * 128 + m * 16) * 256 + col0 + bj * 128, v0, v1); } }
    }
};
struct EpiCmp {
    bf16_t* O;
    DI void operator()(const Acc& acc, const Unit& u, int wr, int wc, int fr, int fq) const {
        if (wc >= 2) return;
        const int row0 = u.pm * 256 + wr * 64 + fr, col0 = wc * 32 + 8 * fq;
#pragma unroll
        EPI_LOOP_ROWS { const int row = row0 + ai * 128 + m * 16; f32x4 v0 = acc[ai][0][m][0], v1 = acc[ai][0][m][1];
            if ((row & 127) == 127) { v0 = (f32x4){0.f, 0.f, 0.f, 0.f}; v1 = v0; }
            st8_bf16(O + (size_t)row * 64 + col0, v0, v1); }
    }
};


#define XB_TMO      128
#define XB_XCNT(j)  (256  + 64 * (j))
#define XB_XSUB(j)  (1280 + 64 * (j))
#define XB_XGEN(j)  (2304 + 64 * (j))
#define XB_TOP      3328
#define XB_TOPGEN   3392
#define XCD_BAR_WORDS 3456
#define XB_SPIN_CAP (1u << 22)
DI unsigned xb_ld(unsigned* p)              { return __hip_atomic_load(p, __ATOMIC_RELAXED, __HIP_MEMORY_SCOPE_AGENT); }
DI unsigned xb_add(unsigned* p, unsigned v) { return __hip_atomic_fetch_add(p, v, __ATOMIC_RELAXED, __HIP_MEMORY_SCOPE_AGENT); }
DI unsigned xb_xcc_id() { return (unsigned)__builtin_amdgcn_s_getreg((3 << 11) | 20) & 0xFu; }
#define XB_SPIN(cond, bar) do { unsigned _sp = 0; while (cond) { __builtin_amdgcn_s_sleep(1); \
    if ((++_sp & 255u) == 0u) { if (xb_ld(&(bar)[XB_TMO])) break; if (_sp > XB_SPIN_CAP) { atomicAdd(&(bar)[XB_TMO], 1u); break; } } } } while (0)
struct XcdBarrier { unsigned* bar; unsigned x; volatile LAS unsigned* st; };
DI XcdBarrier xcd_barrier_post(unsigned* bar, volatile LAS unsigned* st) {
    XcdBarrier b; b.bar = bar; b.x = xb_xcc_id(); b.st = st;
    if (threadIdx.x == 0) (void)xb_add(&bar[XB_XCNT(b.x)], 1u);
    return b;
}
DI void xcd_barrier_complete(unsigned* bar, unsigned x, unsigned& nloc, unsigned& nx) {
    const unsigned G = gridDim.x * gridDim.y * gridDim.z;
    unsigned sum, cnt, mine, sp = 0u;
    for (;;) {
        sum = 0u; cnt = 0u; mine = 0u;
#pragma unroll
        for (unsigned j = 0; j < 16; ++j) { const unsigned c = xb_ld(&bar[XB_XCNT(j)]); sum += c; cnt += (c > 0u) ? 1u : 0u; mine = (j == x) ? c : mine; }
        if (sum == G) break;
        __builtin_amdgcn_s_sleep(1);
        if ((++sp & 255u) == 0u) { if (xb_ld(&bar[XB_TMO])) break; if (sp > XB_SPIN_CAP) { atomicAdd(&bar[XB_TMO], 1u); break; } }
    }
    nloc = mine > 0u ? mine : 1u; nx = cnt > 0u ? cnt : 1u;
}
DI void xcd_barrier(const XcdBarrier& b) {
    asm volatile("s_waitcnt vmcnt(0)" ::: "memory");
    __syncthreads();
    if (threadIdx.x == 0) {
        unsigned* bar = b.bar;
        __builtin_amdgcn_s_waitcnt(0);
        unsigned nloc = b.st[0], nx = b.st[1];
        if (nloc == 0u) { xcd_barrier_complete(bar, b.x, nloc, nx); b.st[0] = nloc; b.st[1] = nx; }
        const unsigned old = xb_add(&bar[XB_XSUB(b.x)], 1u);
        const unsigned gen = old / nloc;
        if (old + 1u == (gen + 1u) * nloc) {
            __builtin_amdgcn_fence(__ATOMIC_RELEASE, "agent");
            asm volatile("s_waitcnt vmcnt(0)" ::: "memory");
            const unsigned og = xb_add(&bar[XB_TOP], 1u);
            const unsigned tg = og / nx;
            if (og + 1u == (tg + 1u) * nx) xb_add(&bar[XB_TOPGEN], 1u);
            else XB_SPIN(xb_ld(&bar[XB_TOPGEN]) == tg, bar);
            __builtin_amdgcn_fence(__ATOMIC_ACQUIRE, "agent");
            xb_add(&bar[XB_XGEN(b.x)], 1u);
            asm volatile("s_waitcnt vmcnt(0)" ::: "memory");
        } else {
            XB_SPIN(xb_ld(&bar[XB_XGEN(b.x)]) == gen, bar);
            __builtin_amdgcn_fence(__ATOMIC_ACQUIRE, "agent");
            asm volatile("s_waitcnt vmcnt(0)" ::: "memory");
        }
    }
    __syncthreads();
}

struct Args { const float* in[15]; float* out; unsigned char* ws; int ph_lo, ph_hi; };
enum { I_X = 0, I_LNG, I_LNB, I_PWIN, I_PWGRP, I_PSCALE, I_PWOUT, I_NWIN, I_POSK, I_W1K, I_W2K, I_POSV, I_W1V, I_W2V, I_NWOUT };

DI void transpose_item(const float* W, int ldw, int Nsrc, int Npad, bf16_t* WT, int ldt, LAS float* scr, int item, int lane, const float* rs = nullptr) {
    const int nblk = Npad / 32, kb = item / nblk, nb = item % nblk, k0 = 64 * kb, n0 = 32 * nb;
    const int nn = n0 + (lane & 31); const bool ok = nn < Nsrc;
#pragma unroll 8
    for (int i = 0; i < 32; ++i) { const int kk = 2 * i + (lane >> 5); scr[kk * 33 + (lane & 31)] = ok ? W[(size_t)(k0 + kk) * ldw + nn] * (rs ? rs[k0 + kk] : 1.f) : 0.f; }
    asm volatile("s_waitcnt lgkmcnt(0)" ::: "memory");
    const int c = lane & 7;
#pragma unroll
    for (int j = 0; j < 4; ++j) { const int n = (lane >> 3) + 8 * j; const LAS float* s = scr + (8 * c) * 33 + n;
        u32x4 o; o.x = cvtpk(s[0 * 33], s[1 * 33]); o.y = cvtpk(s[2 * 33], s[3 * 33]); o.z = cvtpk(s[4 * 33], s[5 * 33]); o.w = cvtpk(s[6 * 33], s[7 * 33]);
        *(u32x4*)(WT + (size_t)(n0 + n) * ldt + k0 + 8 * c) = o; }
    asm volatile("s_waitcnt lgkmcnt(0)" ::: "memory");
}

DI void phase_convert(const Args& a, LAS unsigned char* lds, int skip, bool with_wc_ops) {
    unsigned char* ws = a.ws;
    const int tid = threadIdx.x, lane = tid & 63, wave = __builtin_amdgcn_readfirstlane(tid >> 6);
    if ((int)blockIdx.x < skip) return;
    const int G = gridDim.x - skip, gw = ((int)blockIdx.x - skip) * 8 + wave, NGW = G * 8, bidc = (int)blockIdx.x - skip;
    LAS float* scr = (LAS float*)(lds + wave * 16384);
    constexpr int J0 = 16 * 64, J1 = 32 * 32, J2 = 16 * 120, J3 = 32 * 8, J5 = 4 * 8, J7 = 16 * 32, J8 = 8 * 16;
    constexpr int NIT0 = J0 + J1 + J2 + 2 * J3 + 2 * J5 + J7;
    const int NIT = NIT0 + (with_wc_ops ? 4 * J8 : 0);
    for (int it = gw; it < NIT; it += NGW) {
        int r = it;
        if (r < J0) { transpose_item(a.in[I_PWIN] + 2048, 4096, 2048, 2048, (bf16_t*)(ws + WS_WZT), 1024, scr, r, lane); continue; } r -= J0;
        if (r < J1) { transpose_item(a.in[I_PWOUT], 1024, 1024, 1024, (bf16_t*)(ws + WS_WPOT), 2048, scr, r, lane); continue; } r -= J1;
        if (r < J2) { transpose_item(a.in[I_NWIN], NSA_IN, NSA_IN, NSA_PAD, (bf16_t*)(ws + WS_WNIT), 1024, scr, r, lane, a.in[I_LNG]); continue; } r -= J2;
        if (r < J3) { transpose_item(a.in[I_W1K], 256, 256, 256, (bf16_t*)(ws + WS_W1T), 2048, scr, r, lane); continue; } r -= J3;
        if (r < J3) { transpose_item(a.in[I_W1V], 256, 256, 256, (bf16_t*)(ws + WS_W1T) + 256 * 2048, 2048, scr, r, lane); continue; } r -= J3;
        if (r < J5) { transpose_item(a.in[I_W2K], 64, 64, 256, (bf16_t*)(ws + WS_W2T), 256, scr, r, lane); continue; } r -= J5;
        if (r < J5) { transpose_item(a.in[I_W2V], 64, 64, 256, (bf16_t*)(ws + WS_W2T) + 256 * 256, 256, scr, r, lane); continue; } r -= J5;
        if (r < J7) { transpose_item(a.in[I_NWOUT], 1024, 1024, 1024, (bf16_t*)(ws + WS_WNOT), 1024, scr, r, lane); continue; } r -= J7;
        { const int g = r / J8; r -= g * J8; transpose_item(a.in[I_PWGRP] + (size_t)g * 512 * 512, 512, 512, 512, (bf16_t*)(ws + WS_WGT) + (size_t)g * 512 * 512, 512, scr, r, lane); }
    }
    { const float* W = a.in[I_PWIN]; bf16_t* O = (bf16_t*)(ws + WS_WINB);
      if (with_wc_ops) for (int e = bidc * 512 + tid; e < 1024 * 512; e += G * 512) { const int k = e >> 9, c4 = (e & 511) * 4; const f32x4 v = *(const f32x4*)(W + (size_t)k * 4096 + c4);
          u32x2 o; o.x = cvtpk(v[0], v[1]); o.y = cvtpk(v[2], v[3]); *(u32x2*)(O + (size_t)k * 2048 + c4) = o; } }
    for (int wi = gw; wi < (NSA_PAD / 64) * 32; wi += NGW) {
        const int chunk = wi % (NSA_PAD / 64), ks = wi / (NSA_PAD / 64), c = chunk * 64 + lane;
        const float* W = a.in[I_NWIN]; const float* gam = a.in[I_LNG]; const float* bet = a.in[I_LNB];
        float sg = 0.f, sb = 0.f;
        if (c < NSA_IN) {
#pragma unroll
            for (int j = 0; j < 32; ++j) { const int k = ks * 32 + j; const float wv = W[(size_t)k * NSA_IN + c]; sg += gam[k] * wv; sb += bet[k] * wv; } }
        float* part = (float*)(ws + WS_PART); part[(size_t)(ks * 2) * NSA_PAD + c] = sg; part[(size_t)(ks * 2 + 1) * NSA_PAD + c] = sb;
    }
    for (int wi = gw; wi < 64; wi += NGW) {
        const int kv = wi >> 5, n0 = (wi & 31) * 8, kk = lane >> 3, nn = lane & 7;
        const float* pos = a.in[kv ? I_POSV : I_POSK]; const float* w1 = a.in[kv ? I_W1V : I_W1K];
        float s = 0.f;
        for (int j = 0; j < 256; ++j) { const int k = kk + 8 * j; s += pos[k] * w1[(size_t)k * 256 + n0 + nn]; }
        s += __shfl_xor(s, 8); s += __shfl_xor(s, 16); s += __shfl_xor(s, 32);
        if (lane < 8) ((float*)(ws + WS_BIAS))[kv * 256 + n0 + nn] = s;
    }
}

struct SchedOne { const char* A; const char* B; int pm, pn; DI bool next(int i, Unit& u) const { if (i) return false; u.pm = pm; u.pn = pn; u.a = A; u.b = B; return true; } };
DI void wc_unit(const Args& a, LAS unsigned char* lds, int unit) {
    const int tid = threadIdx.x, lane = tid & 63, wave = __builtin_amdgcn_readfirstlane(tid >> 6);
    const int pm = unit >> 2, pn = unit & 3, g = pm >> 1, d0 = (pm & 1) * 256, k0 = pn * 256;
    bf16_t* Ap = (bf16_t*)(a.ws + WS_A) + (size_t)unit * (2 * 256 * 512);
    bf16_t* Bp = Ap + 256 * 512;
    LAS float* scr = (LAS float*)(lds + wave * 16384);
    for (int it = wave; it < 8 * 8; it += 8) transpose_item(a.in[I_PWGRP] + (size_t)g * 512 * 512 + d0, 512, 256, 256, Ap, 512, scr, it, lane);
    { const float* W = a.in[I_PWIN] + (size_t)k0 * 4096 + g * 512;
      for (int e = tid; e < 256 * 128; e += 512) { const int k = e >> 7, c4 = (e & 127) * 4; const f32x4 v = *(const f32x4*)(W + (size_t)k * 4096 + c4);
          u32x2 o; o.x = cvtpk(v[0], v[1]); o.y = cvtpk(v[2], v[3]); *(u32x2*)(Bp + (size_t)k * 512 + c4) = o; } }
    asm volatile("s_waitcnt vmcnt(0) lgkmcnt(0)" ::: "memory"); __syncthreads();
    const pg8::Geom gm{512, 512, 512, 128, 128, 128 * 512 * 2, 128 * 512 * 2};
    SchedOne S{(const char*)Ap, (const char*)Bp, pm, pn};
    EpiWc E{(bf16_t*)(a.ws + WS_WCT), a.in[I_PSCALE]};
    pg8::gemm_phase<EpiWc, SchedOne, false>(lds, gm, S, E);
}

#define POOL_LOAD(ARR, ROW0, GUARD) _Pragma("unroll") for (int j_ = 0; j_ < 8; ++j_) { ARR[j_] = (GUARD) ? __builtin_nontemporal_load((const f32x4*)(xp + (ptrdiff_t)((ROW0) + j_) * DM)) : (f32x4){0.f, 0.f, 0.f, 0.f}; }
#define POOL_INV(W, TL) ((edge_ && (TL) + 1 < (W)) ? 1.f / (float)((TL) + 1) : 1.f / (float)(W))
#define POOL_ST(PTR, V) { const f32x4 m_ = (V); u32x2 o_; o_.x = cvtpk(m_[0], m_[1]); o_.y = cvtpk(m_[2], m_[3]); __builtin_nontemporal_store(o_, (u32x2*)(PTR)); }
#define POOL_PROC(H0, H1, C, ROW0) { \
    _Pragma("unroll") for (int j_ = 0; j_ < 8; ++j_) { \
        const f32x4 x_ = C[j_]; const f32x4 p1_ = j_ >= 1 ? C[j_ >= 1 ? j_ - 1 : 0] : H1[7]; \
        const f32x4 W2 = p1_ + x_, W4 = S4 + x_, W8 = S8 + x_, W16 = S16 + x_; \
        const int tl_ = (ROW0) + j_; const size_t off_ = (size_t)(t0 + tl_) * DM + c4; \
        POOL_ST(XB + off_, x_) \
        POOL_ST(XP + off_, W2 * POOL_INV(2, tl_) - x_) \
        POOL_ST(XP + (size_t)MTOK * DM + off_, W4 * POOL_INV(4, tl_) - x_) \
        POOL_ST(XP + (size_t)2 * MTOK * DM + off_, W8 * POOL_INV(8, tl_) - x_) \
        POOL_ST(XP + (size_t)3 * MTOK * DM + off_, W16 * POOL_INV(16, tl_) - x_) \
        S4 = W4 - (j_ >= 3 ? C[j_ >= 3 ? j_ - 3 : 0] : H1[j_ < 3 ? j_ + 5 : 0]); S8 = W8 - (j_ >= 7 ? C[0] : H1[j_ < 7 ? j_ + 1 : 0]); S16 = W16 - (j_ >= 7 ? H1[0] : H0[j_ < 7 ? j_ + 1 : 0]); } }
DI void phase_pool(const Args& a, int blk, int nblk) {
    const float* X = a.in[I_X]; bf16_t* XB = (bf16_t*)(a.ws + WS_XB); bf16_t* XP = (bf16_t*)(a.ws + WS_XP);
    const int nitems = (MTOK / 64) * 256;
    for (int it = blk * 512 + (int)threadIdx.x; it < nitems; it += nblk * 512) {
        const int chunk = it >> 8, c4 = (it & 255) * 4, t0 = chunk * 64, tl0 = t0 & (SEQ - 1);
        const bool edge_ = tl0 == 0;
        const float* xp = X + (size_t)t0 * DM + c4;
        f32x4 A[8], B[8], C[8], D[8];
        POOL_LOAD(A, -16, !edge_)
        POOL_LOAD(B, -8, !edge_)
        POOL_LOAD(C, 0, true)
        POOL_LOAD(D, 8, true)
        f32x4 S16 = A[1], S8 = B[1], S4 = B[5] + B[6] + B[7];
#pragma unroll
        for (int j = 2; j < 8; ++j) { S16 = S16 + A[j]; S8 = S8 + B[j]; }
        S16 = S16 + B[0] + S8;
        POOL_PROC(A, B, C, 0)  POOL_LOAD(A, 16, true)
        POOL_PROC(B, C, D, 8)  POOL_LOAD(B, 24, true)
        POOL_PROC(C, D, A, 16) POOL_LOAD(C, 32, true)
        POOL_PROC(D, A, B, 24) POOL_LOAD(D, 40, true)
        POOL_PROC(A, B, C, 32) POOL_LOAD(A, 48, true)
        POOL_PROC(B, C, D, 40) POOL_LOAD(B, 56, true)
        POOL_PROC(C, D, A, 48)
        POOL_PROC(D, A, B, 56)
    }
}
#undef POOL_LOAD
#undef POOL_INV
#undef POOL_ST
#undef POOL_PROC

DI void phase_ln(const float* V, float* O, bf16_t* OB, const float* gam, const float* bet) {
    const int lane = threadIdx.x & 63, wave = threadIdx.x >> 6; const int gw = blockIdx.x * 8 + wave, NGW = gridDim.x * 8;
    f32x4 gg[4], bb[4];
#pragma unroll
    for (int j = 0; j < 4; ++j) { gg[j] = *(const f32x4*)(gam + 4 * lane + 256 * j); bb[j] = *(const f32x4*)(bet + 4 * lane + 256 * j); }
    for (int m = gw; m < MTOK; m += NGW) {
        const float* vr = V + (size_t)m * DM + 4 * lane; f32x4 v[4]; float s = 0.f;
#pragma unroll
        for (int j = 0; j < 4; ++j) { v[j] = *(const f32x4*)(vr + 256 * j); s += (v[j][0] + v[j][1]) + (v[j][2] + v[j][3]); }
        const float mean = wave_sum(s) * (1.f / DM); float s2 = 0.f;
#pragma unroll
        for (int j = 0; j < 4; ++j) { v[j] = v[j] - mean; s2 += (v[j][0] * v[j][0] + v[j][1] * v[j][1]) + (v[j][2] * v[j][2] + v[j][3] * v[j][3]); }
        const float rstd = 1.f / sqrtf(wave_sum(s2) * (1.f / DM) + LN_EPS);
#pragma unroll
        for (int j = 0; j < 4; ++j) { const f32x4 y = v[j] * rstd * gg[j] + bb[j]; *(f32x4*)(O + (size_t)m * DM + 4 * lane + 256 * j) = y;
            if (OB) { u32x2 o; o.x = cvtpk(y[0], y[1]); o.y = cvtpk(y[2], y[3]); *(u32x2*)(OB + (size_t)m * DM + 4 * lane + 256 * j) = o; } }
    }
}

DI void phase_final(const float* V, const float* SF, const bf16_t* Y1, float* O, const float* gam, const float* bet) {
    const int lane = threadIdx.x & 63, wave = threadIdx.x >> 6; const int gw = blockIdx.x * 8 + wave, NGW = gridDim.x * 8;
    f32x4 g0[4], b0[4], g1[4], b1[4];
#pragma unroll
    for (int j = 0; j < 4; ++j) { const int c = 4 * lane + 256 * j; g0[j] = *(const f32x4*)(gam + c); b0[j] = *(const f32x4*)(bet + c); g1[j] = *(const f32x4*)(gam + DM + c); b1[j] = *(const f32x4*)(bet + DM + c); }
    for (int m = gw; m < MTOK; m += NGW) {
        float mean0, rstd0; row_stats(SF, m, mean0, rstd0);
        f32x4 v[4]; float s = 0.f;
#pragma unroll
        for (int j = 0; j < 4; ++j) { const size_t off = (size_t)m * DM + 4 * lane + 256 * j; const f32x4 t = __builtin_nontemporal_load((const f32x4*)(V + off)); const u32x2 y = __builtin_nontemporal_load((const u32x2*)(Y1 + off));
            const f32x4 x1 = (t - mean0) * rstd0 * g0[j] + b0[j]; const f32x4 yv = {bf_lo(y.x), bf_hi(y.x), bf_lo(y.y), bf_hi(y.y)};
            v[j] = x1 * DN_ALPHA + yv; s += (v[j][0] + v[j][1]) + (v[j][2] + v[j][3]); }
        const float mean = wave_sum(s) * (1.f / DM); float s2 = 0.f;
#pragma unroll
        for (int j = 0; j < 4; ++j) { v[j] = v[j] - mean; s2 += (v[j][0] * v[j][0] + v[j][1] * v[j][1]) + (v[j][2] * v[j][2] + v[j][3] * v[j][3]); }
        const float rstd = 1.f / sqrtf(wave_sum(s2) * (1.f / DM) + LN_EPS);
#pragma unroll
        for (int j = 0; j < 4; ++j) __builtin_nontemporal_store(v[j] * rstd * g1[j] + b1[j], (f32x4*)(O + (size_t)m * DM + 4 * lane + 256 * j));
    }
}

constexpr int A_KT = 0, A_KT_SZ = 8192;
constexpr int A_VT = 3 * A_KT_SZ, A_VT_SZ = 8192;
constexpr int A_KC = A_VT + 3 * A_VT_SZ;
constexpr int A_VC = A_KC + 16384;
constexpr int A_IMP = 86016;
constexpr int A_TOT = A_IMP + 4 * 64 * 33 * 4;
constexpr int A_SEL = A_TOT + 8192;
constexpr int A_GATE = 132096;
static_assert(A_VC + 16384 <= A_IMP && A_SEL + 512 <= 131072 && A_GATE + 4096 <= 147456, "attention LDS map");
typedef short v4i16_t __attribute__((ext_vector_type(4)));
constexpr int NEGBITS = (int)0xF149F2CAu;
DI int crow(int i, int h) { return (i & 3) + 8 * (i >> 2) + 4 * h; }
DI bf16x8 pack8(const f32x16& x, int s) { u32x4 p; p.x = cvtpk(x[8 * s], x[8 * s + 1]); p.y = cvtpk(x[8 * s + 2], x[8 * s + 3]); p.z = cvtpk(x[8 * s + 4], x[8 * s + 5]); p.w = cvtpk(x[8 * s + 6], x[8 * s + 7]); return __builtin_bit_cast(bf16x8, p); }

DI void qk_tile(const LAS unsigned char* kb_, const bf16x8 (&qf)[4], const f32x16& AK, f32x16 (&S)[2], int r, int h) {
    const int kx = (r >> 1) & 7;
#pragma unroll
    for (int kb = 0; kb < 2; ++kb) {
#pragma unroll
        for (int s = 0; s < 4; ++s) { const bf16x8 kf = *(const LAS bf16x8*)(kb_ + (kb * 32 + r) * 128 + (((2 * s + h) ^ kx) << 4)); S[kb] = MFMA32(kf, qf[s], s == 0 ? AK : S[kb]); }
    }
}
DI void sm_pv_tile(f32x16 (&S)[2], const LAS unsigned char* vb_, f32x16 (&O)[2], float& mrun, float& lrun,
                   int kind, int n, int i, int tq, int qv, float slope2, unsigned selm, const int (&voff)[2][2],
                   bool do_qk, const LAS unsigned char* kn_, const bf16x8 (&qf)[4], const f32x16& AK, f32x16 (&SN)[2], int r, int h) {
    if (n == i || (kind == 0 && n == i - 4)) {
        const int flip = (n == i) ? 0 : -1;
#pragma unroll
        for (int kb = 0; kb < 2; ++kb)
#pragma unroll
            for (int e = 0; e < 16; ++e) { const int v = qv - (32 * kb + crow(e, 0)); S[kb][e] += __builtin_bit_cast(float, ((v ^ flip) >> 31) & NEGBITS); }
    }
    float mx0 = S[0][0], mx1 = S[1][0];
#pragma unroll
    for (int e = 1; e < 16; ++e) { mx0 = fmaxf(mx0, S[0][e]); mx1 = fmaxf(mx1, S[1][e]); }
    const float c32 = 32.f * slope2;
    float mx = fmaxf(mx0, mx1 + c32);
    mx = fmaxf(mx, __shfl_xor(mx, 32));
    const float ct = slope2 * (float)(tq - 64 * n);
    const bool qsel = kind ? ((selm >> n) & 1u) != 0u : true;
    const float mxt = qsel ? mx - ct : -1e30f;
    const bool need = mxt > mrun + 8.f;
    if (__ballot(need) != 0ull) {
        const float mnew = need ? mxt : mrun, alpha = fexp2(mrun - mnew); mrun = mnew; lrun *= alpha;
        O[0] = O[0] * alpha; O[1] = O[1] * alpha;
    }
    const float off = qsel ? mrun + ct : 1e30f;
    qk_tile(kn_, qf, AK, SN, r, h);
    float ls = 0.f;
#pragma unroll
    for (int kb = 0; kb < 2; ++kb)
#pragma unroll
        for (int e = 0; e < 16; ++e) { const float p = fexp2(S[kb][e] - (kb ? off - c32 : off)); S[kb][e] = p; ls += p; }
    lrun += ls;
#pragma unroll
    for (int kb = 0; kb < 2; ++kb)
#pragma unroll
        for (int s2 = 0; s2 < 2; ++s2) { const bf16x8 pb = pack8(S[kb], s2);
#pragma unroll
            for (int dt = 0; dt < 2; ++dt) { const LAS unsigned char* vp = vb_ + (32 * kb + 16 * s2) * 128;
                const s16x4 lo = __builtin_bit_cast(s16x4, __builtin_amdgcn_ds_read_tr16_b64_v4i16((LAS v4i16_t*)(vp + voff[dt][0])));
                const s16x4 hi = __builtin_bit_cast(s16x4, __builtin_amdgcn_ds_read_tr16_b64_v4i16((LAS v4i16_t*)(vp + voff[dt][1])));
                const bf16x8 vf = __builtin_shufflevector(lo, hi, 0, 1, 2, 3, 4, 5, 6, 7); O[dt] = MFMA32(vf, pb, O[dt]); } }
}
DI void tile_dma2(LAS unsigned char* dstK, LAS unsigned char* dstV, const bf16_t* Ksrc, const bf16_t* Vsrc, size_t base, int pitch, int w, int lane) {
    const int row = w * 8 + (lane >> 3), c = (lane & 7) ^ ((row >> 1) & 7);
    const size_t goff = base + (size_t)row * pitch + c * 8;
    __builtin_amdgcn_global_load_lds((const unsigned*)(Ksrc + goff), (LAS unsigned*)(dstK + w * 1024), 16, 0, 0);
    __builtin_amdgcn_global_load_lds((const unsigned*)(Vsrc + goff), (LAS unsigned*)(dstV + w * 1024), 16, 0, 0);
}
DI void cmp_dma(LAS unsigned char* lds, const bf16_t* CMP, int b, int g, int w, int lane) {
    const size_t base = (size_t)((b * 4 + g) * 128) * 64; const bf16_t* vc = CMP + (size_t)8192 * 64;
    tile_dma2(lds + A_KC, lds + A_VC, CMP, vc, base, 64, w, lane);
    tile_dma2(lds + A_KC + 8192, lds + A_VC + 8192, CMP, vc, base + 64 * 64, 64, w, lane);
}
DI void tile_dma(LAS unsigned char* lds, int bufi, const bf16_t* Ksrc, const bf16_t* Vsrc, size_t base, int w, int lane) {
    const int row = w * 8 + (lane >> 3), c = (lane & 7) ^ ((row >> 1) & 7);
    const size_t goff = base + (size_t)row * 256 + c * 8;
    __builtin_amdgcn_global_load_lds((const unsigned*)(Ksrc + goff), (LAS unsigned*)(lds + A_KT + bufi * A_KT_SZ + w * 1024), 16, 0, 0);
    __builtin_amdgcn_global_load_lds((const unsigned*)(Vsrc + goff), (LAS unsigned*)(lds + A_VT + bufi * A_VT_SZ + w * 1024), 16, 0, 0);
}

DI void attn_item(LAS unsigned char* lds, const bf16_t* QB, const bf16_t* KV, const bf16_t* CMP, const bf16_t* SZN, const float* GT, bf16_t* AO, int b, int i, int g, bool first, bool has_nx, int nxb, int nxg) {
    int tid_ = threadIdx.x; asm volatile("" : "+v"(tid_));
    const int tid = tid_, lane = tid & 63, w = __builtin_amdgcn_readfirstlane(tid >> 6), hh = w >> 1, qh = w & 1, r = lane & 31, h = lane >> 5;
    const int ql = 32 * qh + r, tq = 64 * i + ql, head = 4 * g + hh;
    const size_t row = (size_t)b * SEQ + tq;
    const bf16_t* KS = KV + (size_t)2 * MTOK * 256; const bf16_t* VS = KV + (size_t)3 * MTOK * 256;
    const bf16_t* KW = KV + (size_t)4 * MTOK * 256; const bf16_t* VW = KV + (size_t)5 * MTOK * 256;
    if (first) cmp_dma(lds, CMP, b, g, w, lane);
    if (tid == 0) ((LAS unsigned*)(lds + A_SEL))[64] = 0u;
    int voff[2][2];
    { const int q_ = (lane & 15) >> 2, p_ = lane & 3, blk_ = (lane >> 4) & 1, x_ = 2 * h + (q_ >> 1);
#pragma unroll
      for (int dt = 0; dt < 2; ++dt)
#pragma unroll
          for (int hi = 0; hi < 2; ++hi) voff[dt][hi] = (4 * h + q_ + 8 * hi) * 128 + (((4 * dt + 2 * blk_ + (p_ >> 1)) ^ (x_ ^ (4 * hi))) << 4) + (p_ & 1) * 8; }
    bf16x8 qf[4];
    { const bf16_t* qp = QB + row * 1024 + head * 64 + 8 * h;
#pragma unroll
      for (int s = 0; s < 4; ++s) qf[s] = *(const bf16x8*)(qp + 16 * s); }
    const float* gp = GT + row * 48 + head * 3; const float g0 = gp[0];
    { f32x2 g12 = {gp[1], gp[2]}; *(LAS f32x2*)(lds + A_GATE + tid * 8) = g12; }
    const float slope2 = fexp2(-0.5f * (float)(head + 1)) * LOG2E;
    __syncthreads();
    const size_t tbase = ((size_t)b * SEQ) * 256 + g * 64;
    tile_dma(lds, 0, KW, VW, tbase + (size_t)(64 * i) * 256, w, lane);
    if (i > 0) tile_dma(lds, 1, KW, VW, tbase + (size_t)(64 * (i - 1)) * 256, w, lane); else tile_dma(lds, 1, KS, VS, tbase, w, lane);
    f32x16 Oacc[2];
    {
        const int nkb = (i >> 3) + 1;
        f32x16 S[4];
        float mx = -1e30f;
#pragma unroll
        for (int kb = 0; kb < 4; ++kb) {
#pragma unroll
            for (int e = 0; e < 16; ++e) S[kb][e] = 0.f;
            if (kb < nkb) {
#pragma unroll
                for (int s = 0; s < 4; ++s) { const bf16x8 kf = *(const LAS bf16x8*)(lds + A_KC + (kb >> 1) * 8192 + ((kb & 1) * 32 + r) * 128 + (((2 * s + h) ^ ((r >> 1) & 7)) << 4)); S[kb] = MFMA32(kf, qf[s], S[kb]); }
#pragma unroll
                for (int e = 0; e < 16; ++e) { const int c = 32 * kb + crow(e, h); const int dist = tq - (16 * c + 31); const float sv = S[kb][e] - slope2 * (float)dist;
                    S[kb][e] = sv + __builtin_bit_cast(float, (dist >> 31) & NEGBITS); mx = fmaxf(mx, S[kb][e]); }
            }
        }
        mx = fmaxf(fmaxf(mx, __shfl_xor(mx, 32)), -1e20f);
        float l = 0.f;
#pragma unroll
        for (int kb = 0; kb < 4; ++kb) if (kb < nkb) {
#pragma unroll
            for (int e = 0; e < 16; ++e) { const float p = fexp2(S[kb][e] - mx); S[kb][e] = p; l += p; } }
        l += __shfl_xor(l, 32);
        const float inv = l > 0.f ? 1.f / l : 0.f;
        LAS float* imp = (LAS float*)(lds + A_IMP) + (hh * 64 + ql) * 33;
        float carry = 0.f;
#pragma unroll
        for (int kb = 0; kb < 4; ++kb) {
            if (kb < nkb) { S[kb] = S[kb] * inv;
#pragma unroll
                for (int ig = 0; ig < 4; ++ig) { const float gsum = (S[kb][4 * ig] + S[kb][4 * ig + 1]) + (S[kb][4 * ig + 2] + S[kb][4 * ig + 3]); const float plv = __shfl_xor(S[kb][4 * ig + 3], 32);
                    imp[8 * kb + 2 * ig + h] = gsum + (h ? plv : carry); carry = plv; } }
            else {
#pragma unroll
                for (int ig = 0; ig < 4; ++ig) { imp[8 * kb + 2 * ig + h] = (h == 0 && ig == 0) ? carry : 0.f; if (ig == 0) carry = 0.f; } } }
        f32x16 O[2];
#pragma unroll
        for (int dt = 0; dt < 2; ++dt)
#pragma unroll
            for (int e = 0; e < 16; ++e) O[dt][e] = 0.f;
#pragma unroll
        for (int kb = 0; kb < 4; ++kb) if (kb < nkb) {
#pragma unroll
            for (int s2 = 0; s2 < 2; ++s2) { const bf16x8 pb = pack8(S[kb], s2);
#pragma unroll
                for (int dt = 0; dt < 2; ++dt) { const LAS unsigned char* vp = lds + A_VC + (kb >> 1) * 8192 + ((kb & 1) * 32 + 16 * s2) * 128;
                    const s16x4 lo = __builtin_bit_cast(s16x4, __builtin_amdgcn_ds_read_tr16_b64_v4i16((LAS v4i16_t*)(vp + voff[dt][0])));
                    const s16x4 hi = __builtin_bit_cast(s16x4, __builtin_amdgcn_ds_read_tr16_b64_v4i16((LAS v4i16_t*)(vp + voff[dt][1])));
                    const bf16x8 vf = __builtin_shufflevector(lo, hi, 0, 1, 2, 3, 4, 5, 6, 7); O[dt] = MFMA32(vf, pb, O[dt]); } } }
        Oacc[0] = O[0] * g0; Oacc[1] = O[1] * g0;
    }
#define LBAR() do { asm volatile("s_waitcnt lgkmcnt(0)" ::: "memory"); __builtin_amdgcn_s_barrier(); } while (0)
    LBAR();
    if (has_nx) cmp_dma(lds, CMP, nxb, nxg, w, lane);
    {
        LAS float* IMP = (LAS float*)(lds + A_IMP); LAS float* TOT = (LAS float*)(lds + A_TOT); LAS unsigned* SEL = (LAS unsigned*)(lds + A_SEL);
        const int n = tid & 31;
#pragma unroll
        for (int ps = 0; ps < 4; ++ps) { const int q = ps * 16 + (tid >> 5);
            float v = (IMP[(0 * 64 + q) * 33 + n] + IMP[(1 * 64 + q) * 33 + n]) + (IMP[(2 * 64 + q) * 33 + n] + IMP[(3 * 64 + q) * 33 + n]);
            if (n == 0 || n == i || n == i - 1) v = 1e9f; else if (n > i) v = -1e30f;
            TOT[q * 32 + n] = v; }
        LBAR();
        unsigned uni = 0u;
#pragma unroll
        for (int ps = 0; ps < 4; ++ps) { const int q = ps * 16 + (tid >> 5); const float my = TOT[q * 32 + n]; int rank = 0;
#pragma unroll
            for (int j = 0; j < 8; ++j) { if (4 * j > i) break;
                const f32x4 t4 = *(const LAS f32x4*)(TOT + q * 32 + 4 * j);
#pragma unroll
                for (int e = 0; e < 4; ++e) { const int n2 = 4 * j + e; rank += (t4[e] > my || (t4[e] == my && n2 < n)) ? 1 : 0; } }
            const unsigned long long bal = __ballot(rank < 8);
            const unsigned lo = (unsigned)bal, hi = (unsigned)(bal >> 32);
            if (lane == 0) SEL[q] = lo; if (lane == 32) SEL[q] = hi;
            uni |= lo | hi; }
        const unsigned allowed = (i >= 31) ? 0xffffffffu : ((2u << i) - 1u);
        if (lane == 0) atomicOr((unsigned*)(SEL + 64), uni & allowed);
        LBAR();
    }
#undef LBAR
    const unsigned uni = __builtin_amdgcn_readfirstlane(((LAS unsigned*)(lds + A_SEL))[64]);
    const unsigned selm = ((LAS unsigned*)(lds + A_SEL))[ql];
    f32x16 AK;
#pragma unroll
    for (int e = 0; e < 16; ++e) AK[e] = slope2 * (float)crow(e, h);
    const int nlo = i - 4 < 0 ? 0 : i - 4;
    float mrun = -1e20f, lrun = 0.f; f32x16 O[2];
#pragma unroll
    for (int dt = 0; dt < 2; ++dt)
#pragma unroll
        for (int e = 0; e < 16; ++e) O[dt][e] = 0.f;
    const int qv = ql - 4 * h;
    int ck = 0, cn = i;
    int k1, n1; bool ok1 = true;
    if (cn > nlo) { k1 = 0; n1 = cn - 1; } else { k1 = 1; n1 = 31 - __builtin_clz(uni); }
    int k2 = k1, n2 = 0; bool ok2 = true;
#define TS_ADV(kk, nn, okk, ko, no, oko) do { ko = kk; no = 0; oko = okk; if (okk) { if (kk == 0) { if (nn > nlo) no = nn - 1; else { ko = 1; no = 31 - __builtin_clz(uni); } } \
        else { const unsigned rem_ = uni & ((1u << nn) - 1u); if (rem_ == 0u) oko = false; else no = 31 - __builtin_clz(rem_); } } } while (0)
    TS_ADV(k1, n1, ok1, k2, n2, ok2);
    int bc = 0;
    f32x16 Sa[2], Sb[2];
    asm volatile("s_waitcnt vmcnt(0)" ::: "memory"); __builtin_amdgcn_s_barrier();
    qk_tile(lds + A_KT, qf, AK, Sa, r, h);
#define TILE_STEP(SC, SN) { \
        asm volatile("s_waitcnt vmcnt(0)" ::: "memory");        \
        __builtin_amdgcn_s_barrier();                             \
        { const bool pf_ = ok1 && ok2; const int pk_ = pf_ ? k2 : ck, pn_ = pf_ ? n2 : cn; \
          int b2 = bc + 2; b2 = b2 >= 3 ? b2 - 3 : b2; \
          tile_dma(lds, b2, pk_ ? KS : KW, pk_ ? VS : VW, tbase + (size_t)(64 * pn_) * 256, w, lane); } \
        { const int b1 = bc + 1 >= 3 ? 0 : bc + 1; \
          sm_pv_tile(SC, lds + A_VT + bc * A_VT_SZ, O, mrun, lrun, ck, cn, i, tq, qv, slope2, selm, voff, ok1, lds + A_KT + b1 * A_KT_SZ, qf, AK, SN, r, h); } \
        if (!ok1 || k1 != ck) {       \
            const float lt = lrun + __shfl_xor(lrun, 32); const float sc = *(const LAS float*)(lds + A_GATE + tid * 8 + (ck ? 0 : 4)) * (lt > 0.f ? 1.f / lt : 0.f); \
            Oacc[0] = Oacc[0] + O[0] * sc; Oacc[1] = Oacc[1] + O[1] * sc; \
            mrun = -1e20f; lrun = 0.f; \
            _Pragma("unroll") for (int dt = 0; dt < 2; ++dt) _Pragma("unroll") for (int e = 0; e < 16; ++e) O[dt][e] = 0.f; \
        } \
        if (!ok1) break; \
        ck = k1; cn = n1; k1 = k2; n1 = n2; ok1 = ok2; { int k3, n3; bool ok3; TS_ADV(k2, n2, ok2, k3, n3, ok3); k2 = k3; n2 = n3; ok2 = ok3; } \
        bc = bc + 1 >= 3 ? 0 : bc + 1; }
    for (;;) {
        TILE_STEP(Sa, Sb)
        TILE_STEP(Sb, Sa)
    }
#undef TILE_STEP
#undef TS_ADV
    asm volatile("s_waitcnt vmcnt(0)" ::: "memory");
    __builtin_amdgcn_s_barrier();
    {
        LAS unsigned char* st = lds + (w < 5 ? w * 8704 : A_IMP + (w - 5) * 8704);
#pragma unroll
        for (int dt = 0; dt < 2; ++dt)
#pragma unroll
            for (int ig = 0; ig < 4; ++ig) { f32x4 v = {Oacc[dt][4 * ig], Oacc[dt][4 * ig + 1], Oacc[dt][4 * ig + 2], Oacc[dt][4 * ig + 3]};
                *(LAS f32x4*)(st + r * 272 + (32 * dt + 8 * ig + 4 * h) * 4) = v; }
        asm volatile("s_waitcnt lgkmcnt(0)" ::: "memory");
        const int qq = lane >> 3, dc = lane & 7;
#pragma unroll
        for (int j = 0; j < 4; ++j) { const int qr = 8 * j + qq;
            const size_t off = ((size_t)b * SEQ + 64 * i + 32 * qh + qr) * 1024 + head * 64 + dc * 8;
            const u32x4 z = *(const u32x4*)(SZN + off);
            const f32x4 o0 = *(const LAS f32x4*)(st + qr * 272 + dc * 32), o1 = *(const LAS f32x4*)(st + qr * 272 + dc * 32 + 16);
            u32x4 o; o.x = cvtpk(o0[0] * bf_lo(z.x), o0[1] * bf_hi(z.x)); o.y = cvtpk(o0[2] * bf_lo(z.y), o0[3] * bf_hi(z.y));
            o.z = cvtpk(o1[0] * bf_lo(z.z), o1[1] * bf_hi(z.z)); o.w = cvtpk(o1[2] * bf_lo(z.w), o1[3] * bf_hi(z.w));
            *(u32x4*)(AO + off) = o; }
    }
}

DI void phase_attn(const Args& a, LAS unsigned char* lds) {
    unsigned char* ws = a.ws; const int G = gridDim.x;
    const bf16_t* QB = (const bf16_t*)(ws + WS_QB); const bf16_t* KV = (const bf16_t*)(ws + WS_KV); const bf16_t* CMP = (const bf16_t*)(ws + WS_CMP);
    const bf16_t* SZN = (const bf16_t*)(ws + WS_SZN); const float* GT = (const float*)(ws + WS_GATE); bf16_t* AO = (bf16_t*)(ws + WS_XB);
    for (int k = 0;; ++k) {
        const long idx = (long)k * G + blockIdx.x; if (idx >= 2048) break;
        const int grp = (int)(idx >> 6), sub = (int)(idx & 63);
        const int per = G >> 6;
        int lvl = grp;
        if (per > 1 && (k & 1)) { const int base = (grp / per) * per; lvl = base + (per - 1 - (grp - base)); if (lvl > 31) lvl = grp; }
        const int i = 31 - lvl, b = sub >> 2, g = (sub + k) & 3;
        const long idx2 = (long)(k + 1) * G + blockIdx.x; const bool has_nx = idx2 < 2048; const int sub2 = (int)(idx2 & 63);
        attn_item(lds, QB, KV, CMP, SZN, GT, AO, b, i, g, k == 0, has_nx, sub2 >> 2, (sub2 + k + 1) & 3);
    }
}

constexpr int LDS_BYTES = 147456, LDS_CTL = 131072;
constexpr int N_PHASES = 12;
__global__ void __launch_bounds__(512, 2) fwd_kernel(Args a) {
    extern __shared__ __attribute__((aligned(16))) unsigned char lds_raw[];
    LAS unsigned char* lds = (LAS unsigned char*)lds_raw;
    unsigned char* ws = a.ws; const int G = gridDim.x, bid = blockIdx.x;
    const int lo = a.ph_lo, hi = a.ph_hi;
#define IN(k) (lo <= (k) && (k) < hi)
    if (threadIdx.x < 8) ((LAS unsigned*)(lds + LDS_CTL))[threadIdx.x] = 0u;
    __syncthreads();
    XcdBarrier bar = xcd_barrier_post((unsigned*)(ws + WS_CTL), (volatile LAS unsigned*)(lds + LDS_CTL));
#define SEAM(k) do { if (IN(k) && IN((k) + 1)) { if ((k) == 0) cg::this_grid().sync(); else xcd_barrier(bar); } } while (0)
    const char* XB = (const char*)(ws + WS_XB);
    const bool wc_private = G >= 64;
    if (IN(0)) {
        if (wc_private) { if (bid < 32) wc_unit(a, lds, bid); phase_convert(a, lds, 32, false); }
        else phase_convert(a, lds, 0, true);
        phase_pool(a, bid, G);
    }
    SEAM(0);
    if (IN(1) && !wc_private) {
        const pg8::Geom g{512, 512, 2048, 128, 128, 128 * 512 * 2, 128 * 2048 * 2};
        SchedWc S{G, bid, (const char*)(ws + WS_WGT), (const char*)(ws + WS_WINB)};
        EpiWc E{(bf16_t*)(ws + WS_WCT), a.in[I_PSCALE]};
        pg8::gemm_phase<EpiWc, SchedWc, false>(lds, g, S, E);
    }
    if (!wc_private) SEAM(1);
    if (IN(2)) { const float* part = (const float*)(ws + WS_PART); float* gb = (float*)(ws + WS_GB);
        for (int e = bid * 512 + (int)threadIdx.x; e < 2 * NSA_PAD; e += G * 512) { const int which = e / NSA_PAD, c = e - which * NSA_PAD; float t = 0.f;
#pragma unroll 8
            for (int ks = 0; ks < 32; ++ks) t += part[(size_t)(ks * 2 + which) * NSA_PAD + c];
            gb[e] = t; } }
    if (IN(2)) {
        const pg8::Geom g{1024, 1024, 1024, 128, 128, 128 * 1024 * 2, 128 * 1024 * 2};
        SchedZU S{G, bid, XB, (const char*)(ws + WS_XP), (const char*)(ws + WS_WZT), (const char*)(ws + WS_WCT)};
        EpiZU E{(bf16_t*)(ws + WS_A), (bf16_t*)a.out + (size_t)bid * (256 * 256)};
        pg8::gemm_phase<EpiZU, SchedZU, true>(lds, g, S, E);
    }
    SEAM(2);
    if (IN(4)) {
        const pg8::Geom g{2048, 2048, 2048, 128, 128, 128 * 2048 * 2, 128 * 2048 * 2};
        SchedPlain S{MTOK / 256, 4, G, bid, (const char*)(ws + WS_A), (const char*)(ws + WS_WPOT), (size_t)256 * 2048 * 2, (size_t)256 * 2048 * 2};
        EpiRes0 E{(float*)(ws + WS_V), (bf16_t*)(ws + WS_XB), a.in[I_X], (float*)(ws + WS_STATS)};
        pg8::gemm_phase<EpiRes0, SchedPlain, true>(lds, g, S, E);
    }
    SEAM(4);
    if (IN(5)) { const float* ST = (const float*)(ws + WS_STATS); float* SF = (float*)(ws + WS_SF);
        for (int row = bid * 512 + (int)threadIdx.x; row < MTOK; row += G * 512) { const f32x4* p = (const f32x4*)(ST + (size_t)row * 32); float s_ = 0.f, q_ = 0.f;
#pragma unroll
            for (int j = 0; j < 8; ++j) { const f32x4 t = p[j]; s_ += t[0] + t[2]; q_ += t[1] + t[3]; }
            const float mean = s_ * (1.f / DM), var = q_ * (1.f / DM) - mean * mean; f32x2 o = {mean, 1.f / sqrtf(var + LN_EPS)}; *(f32x2*)(SF + (size_t)row * 2) = o; } }
    SEAM(5);
    if (IN(6)) {
        const pg8::Geom g{1024, 1024, 1024, 128, 128, 128 * 1024 * 2, 128 * 1024 * 2};
        EpiNsaIn E{(bf16_t*)(ws + WS_QB), (bf16_t*)(ws + WS_KV), (bf16_t*)(ws + WS_SZN), (float*)(ws + WS_GATE), (const float*)(ws + WS_SF), (const float*)(ws + WS_GB)};
        if (G == 256) { SchedNsaA S{G, bid, XB, (const char*)(ws + WS_WNIT)}; pg8::gemm_phase<EpiNsaIn, SchedNsaA, true>(lds, g, S, E); }
        else { SchedPlain S{MTOK / 256, NSA_PAD / 256, G, bid, XB, (const char*)(ws + WS_WNIT), (size_t)256 * 1024 * 2, (size_t)256 * 1024 * 2}; pg8::gemm_phase<EpiNsaIn, SchedPlain, true>(lds, g, S, E); }
    }
    SEAM(6);
    if (IN(7) && G == 256) {
        const pg8::Geom g{1024, 1024, 1024, 128, 128, 128 * 1024 * 2, 128 * 1024 * 2};
        EpiNsaIn E{(bf16_t*)(ws + WS_QB), (bf16_t*)(ws + WS_KV), (bf16_t*)(ws + WS_SZN), (float*)(ws + WS_GATE), (const float*)(ws + WS_SF), (const float*)(ws + WS_GB)};
        SchedNsaB S{bid, XB, (const char*)(ws + WS_WNIT)}; pg8::gemm_phase<EpiNsaIn, SchedNsaB, true>(lds, g, S, E);
    }
    if (IN(7)) {
        const pg8::Geom g{2048, 4096, 2048, 512, 128, 128, 128 * 2048 * 2};
        SchedCmp1 S{G, bid, (const char*)(ws + WS_KV), (const char*)(ws + WS_W1T)};
        EpiHid E{(bf16_t*)(ws + WS_HID), (const float*)(ws + WS_BIAS)};
        pg8::gemm_phase<EpiHid, SchedCmp1, false>(lds, g, S, E);
        asm volatile("s_waitcnt vmcnt(0)" ::: "memory"); __syncthreads();
    }
    if (IN(8)) {
        const pg8::Geom g{256, 256, 256, 128, 128, 128 * 256 * 2, 128 * 256 * 2};
        SchedCmp2 S{G, bid, (const char*)(ws + WS_HID), (const char*)(ws + WS_W2T)};
        EpiCmp E{(bf16_t*)(ws + WS_CMP)};
        pg8::gemm_phase<EpiCmp, SchedCmp2, false>(lds, g, S, E);
    }
    SEAM(8);
    if (IN(9)) phase_attn(a, lds);
    SEAM(9);
    if (IN(10)) {
        const pg8::Geom g{1024, 1024, 1024, 128, 128, 128 * 1024 * 2, 128 * 1024 * 2};
        SchedPlain S{MTOK / 256, 4, G, bid, XB, (const char*)(ws + WS_WNOT), (size_t)256 * 1024 * 2, (size_t)256 * 1024 * 2};
        EpiBf16 E{(bf16_t*)(ws + WS_QB)};
        pg8::gemm_phase<EpiBf16, SchedPlain, true>(lds, g, S, E);
    }
    SEAM(10);
    if (IN(11)) phase_final((const float*)(ws + WS_V), (const float*)(ws + WS_SF), (const bf16_t*)(ws + WS_QB), a.out, a.in[I_LNG], a.in[I_LNB]);
#undef IN
#undef SEAM
}

extern "C" void kernel_launch(void* const* d_in, const int* in_sizes, int n_in, void* d_out, int out_size, void* d_ws, size_t ws_size, hipStream_t stream) {
    static int grid = 0;
    if (grid == 0) {
        if (n_in != 15 || out_size != MTOK * DM || ws_size < WS_END) { fprintf(stderr, "kernel_launch: unexpected problem shape (n_in %d, out %d, ws %zu)\n", n_in, out_size, ws_size); grid = -1; return; }
        int dev = 0, cus = 0, per_cu = 0;
        if (hipGetDevice(&dev) != hipSuccess || hipDeviceGetAttribute(&cus, hipDeviceAttributeMultiprocessorCount, dev) != hipSuccess) { grid = -1; return; }
        if (hipFuncSetAttribute((const void*)fwd_kernel, hipFuncAttributeMaxDynamicSharedMemorySize, LDS_BYTES) != hipSuccess) { fprintf(stderr, "kernel_launch: hipFuncSetAttribute failed\n"); grid = -1; return; }
        if (hipOccupancyMaxActiveBlocksPerMultiprocessor(&per_cu, (const void*)fwd_kernel, 512, LDS_BYTES) != hipSuccess || per_cu < 1) per_cu = 1;
        (void)hipGetLastError();
        grid = cus * per_cu;
    }
    if (grid < 0) return;
    if (hipMemsetAsync((char*)d_ws + WS_CTL, 0, 16384, stream) != hipSuccess) { fprintf(stderr, "kernel_launch: memset failed\n"); return; }
    Args a{};
    for (int i = 0; i < 15; ++i) a.in[i] = (const float*)d_in[i];
    a.out = (float*)d_out; a.ws = (unsigned char*)d_ws;
#if MK_SINGLE
    a.ph_lo = 0; a.ph_hi = N_PHASES;
    void* args[] = {&a};
    hipError_t e = hipLaunchCooperativeKernel((const void*)fwd_kernel, dim3(grid), dim3(512), args, LDS_BYTES, stream);
    if (e != hipSuccess) fprintf(stderr, "cooperative launch failed: %s (grid %d)\n", hipGetErrorString(e), grid);
#else
    for (int p = 0; p < N_PHASES; ++p) { a.ph_lo = p; a.ph_hi = p + 1;
        const int reps = ((REP_MASK >> p) & 1) ? 2 : 1;
        for (int r = 0; r < reps; ++r) hipLaunchKernelGGL(fwd_kernel, dim3(grid), dim3(512), LDS_BYTES, stream, a); }
#endif
}
```

```cpp
#include <hip/hip_runtime.h>
#include <hip/hip_cooperative_groups.h>
#include <cstdio>
#include <cstdint>
namespace cg = cooperative_groups;

#ifndef REP_MASK
#define REP_MASK 0
#endif
#ifndef MK_SINGLE
#define MK_SINGLE 1
#endif

#define LAS __attribute__((address_space(3)))
#define DI __device__ __forceinline__
typedef unsigned short bf16_t;
typedef short bf16x8 __attribute__((ext_vector_type(8)));
typedef short s16x4 __attribute__((ext_vector_type(4)));
typedef float f32x2 __attribute__((ext_vector_type(2)));
typedef float f32x4 __attribute__((ext_vector_type(4)));
typedef float f32x16 __attribute__((ext_vector_type(16)));
typedef unsigned u32x2 __attribute__((ext_vector_type(2)));
typedef unsigned u32x4 __attribute__((ext_vector_type(4)));
typedef __bf16 bf16x2_t __attribute__((ext_vector_type(2)));

constexpr int SEQ = 2048, NB = 16, DM = 1024, MTOK = NB * SEQ;
constexpr int DPOOL = 2048, NSA_IN = 3632, NSA_PAD = 3840;
constexpr int NCMP_PAD = 128;
constexpr float DN_ALPHA = 1.41421356237309515f;
constexpr float LN_EPS = 1e-5f;
constexpr float LOG2E = 1.4426950408889634f;

constexpr size_t MiB = 1u << 20;
constexpr size_t WS_CTL  = 0;
constexpr size_t WS_WINB = 1 * MiB;
constexpr size_t WS_WZT  = 5 * MiB;
constexpr size_t WS_WGT  = 9 * MiB;
constexpr size_t WS_WCT  = 11 * MiB;
constexpr size_t WS_WPOT = 15 * MiB;
constexpr size_t WS_WNIT = 19 * MiB;
constexpr size_t WS_W1T  = 27 * MiB;
constexpr size_t WS_W2T  = 29 * MiB;
constexpr size_t WS_WNOT = 30 * MiB;
constexpr size_t WS_BIAS = 32 * MiB;
constexpr size_t WS_STATS = 34 * MiB;
constexpr size_t WS_GB   = 33 * MiB;
constexpr size_t WS_SF   = 39 * MiB;
constexpr size_t WS_PART = 38 * MiB;
constexpr size_t WS_XB   = 40 * MiB;
constexpr size_t WS_XP   = 104 * MiB;
constexpr size_t WS_V    = 104 * MiB;
constexpr size_t WS_A    = 360 * MiB;
constexpr size_t WS_QB   = 232 * MiB;
constexpr size_t WS_SZN  = 296 * MiB;
constexpr size_t WS_KV   = 360 * MiB;
constexpr size_t WS_GATE = 456 * MiB;
constexpr size_t WS_HID  = 462 * MiB;
constexpr size_t WS_CMP  = 470 * MiB;
constexpr size_t WS_END  = 472 * MiB;

DI unsigned cvtpk(float lo, float hi) { f32x2 v = {lo, hi}; bf16x2_t b = __builtin_convertvector(v, bf16x2_t); return __builtin_bit_cast(unsigned, b); }
DI float bf_lo(unsigned u) { return __builtin_bit_cast(float, u << 16); }
DI float bf_hi(unsigned u) { return __builtin_bit_cast(float, u & 0xffff0000u); }
DI float fexp2(float x) { return __builtin_amdgcn_exp2f(x); }
DI float sigmoid_f(float v) { return __builtin_amdgcn_rcpf(1.f + fexp2(-v * LOG2E)); }
DI float silu_f(float v) { return v * sigmoid_f(v); }
DI float wave_sum(float v) {
#pragma unroll
    for (int o = 1; o < 64; o <<= 1) v += __shfl_xor(v, o);
    return v;
}
#define MFMA32(a, b, c) __builtin_amdgcn_mfma_f32_32x32x16_bf16((a), (b), (c), 0, 0, 0)

namespace pg8 {
constexpr int BM = 256, BK = 64, HALF = 128, HTB = HALF * BK * 2, STAGE_BYTES = 8 * HTB, NXCD = 8, WGM = 8;
DI int lds_byte(int r, int c) { const int st = (r >> 4) * 2 + (c >> 5), rr = r & 15, cc = c & 31, ob = rr * 64 + cc * 2; return st * 1024 + (ob ^ (((ob >> 9) & 1) << 5)); }
DI void stage_rc(int b, int& R, int& C) { const int st = b / 1024, sb = b % 1024, swz = sb ^ (((sb >> 9) & 1) << 5); R = (st >> 1) * 16 + swz / 64; C = (st & 1) * 32 + (swz % 64) / 2; }
DI int perm32(int rho) { const int n = rho >> 4, i = rho & 15; return 8 * (i >> 2) + 4 * n + (i & 3); }

struct Unit { const char* a; const char* b; int pm, pn; };
struct Geom { int K; unsigned lda, ldb; unsigned kstepA, kstepB; unsigned hstepA, hstepB; };

DI bool order_next(int nM, int nN, int G, int c, int i, int& pm, int& pn) {
    const int nwg = nM * nN; const long L = (long)i * G + c; if (L >= nwg) return false;
    int wgid = (int)L; { const int q = nwg / NXCD, r = nwg % NXCD, xcd = wgid % NXCD, off = wgid / NXCD; wgid = (xcd < r ? xcd * (q + 1) : r * (q + 1) + (xcd - r) * q) + off; }
    const int nig = WGM * nN, gid = wgid / nig, fm = gid * WGM, gsz = (nM - fm) < WGM ? (nM - fm) : WGM;
    pm = fm + ((wgid % nig) % gsz); pn = (wgid % nig) / gsz; return true;
}

DI void order_map(int nM, int nN, int L, int& pm, int& pn) {
    const int nwg = nM * nN; int wgid = L; { const int q = nwg / NXCD, r = nwg % NXCD, xcd = wgid % NXCD, off = wgid / NXCD; wgid = (xcd < r ? xcd * (q + 1) : r * (q + 1) + (xcd - r) * q) + off; }
    const int nig = WGM * nN, gid = wgid / nig, fm = gid * WGM, gsz = (nM - fm) < WGM ? (nM - fm) : WGM;
    pm = fm + ((wgid % nig) % gsz); pn = (wgid % nig) / gsz;
}
template <class Epi, class Sched, bool ALIGN_EPI>
DI void gemm_phase(LAS unsigned char* lds, const Geom g, const Sched& S, const Epi& E) {
    const int tid = threadIdx.x, wid = __builtin_amdgcn_readfirstlane(tid >> 6), lane = tid & 63, wr = wid >> 2, wc = wid & 3, fr = lane & 15, fq = lane >> 4;
    const int nt = g.K / BK;
    unsigned voffA[2], voffB[2];
#pragma unroll
    for (int i = 0; i < 2; ++i) { int R, C; stage_rc(tid * 16 + i * 8192, R, C); const int Rb = (R & ~31) + perm32(R & 31);
        voffA[i] = (unsigned)(R * g.lda + C) * 2u; voffB[i] = (unsigned)(Rb * g.ldb + C) * 2u; }
    const size_t kA = g.kstepA, kB = g.kstepB, hA = g.hstepA, hB = g.hstepB;
    const unsigned ldsw = (unsigned)wid * 1024u;
    const int aoff = lds_byte(wr * 64 + fr, fq * 8), boff = lds_byte(wc * 32 + fr, fq * 8);
#define PG8_SA(b, h) (((b) * 2 + (h)) * HTB)
#define PG8_SB(b, h) ((4 + (b) * 2 + (h)) * HTB)
#define PG8_STAGE(bufoff, gbase, voff) do { _Pragma("unroll") for (int _i = 0; _i < 2; ++_i) \
        __builtin_amdgcn_global_load_lds((const unsigned*)((const char*)(gbase) + (voff)[_i]), (LAS unsigned*)(lds + (bufoff) + ldsw + _i * 8192), 16, 0, 0); } while (0)
#define PG8_LDA(dst, b, h) do { _Pragma("unroll") for (int m = 0; m < 4; ++m) _Pragma("unroll") for (int k = 0; k < 2; ++k) dst[m][k] = *(const LAS bf16x8*)(lds + PG8_SA(b, h) + aoff + m * 2048 + k * 1024); } while (0)
#define PG8_LDB(dst, b, h) do { _Pragma("unroll") for (int n = 0; n < 2; ++n) _Pragma("unroll") for (int k = 0; k < 2; ++k) dst[n][k] = *(const LAS bf16x8*)(lds + PG8_SB(b, h) + boff + n * 2048 + k * 1024); } while (0)
#define PG8_MMA(ai, bj, At, Bt) do { __builtin_amdgcn_s_setprio(1); _Pragma("unroll") for (int m = 0; m < 4; ++m) _Pragma("unroll") for (int n = 0; n < 2; ++n) _Pragma("unroll") for (int k = 0; k < 2; ++k) \
        acc[ai][bj][m][n] = __builtin_amdgcn_mfma_f32_16x16x32_bf16(Bt[n][k], At[m][k], acc[ai][bj][m][n], 0, 0, 0); __builtin_amdgcn_s_setprio(0); } while (0)
#define PG8_WAIT_V(n) asm volatile("s_waitcnt vmcnt(" #n ")" ::: "memory")
#define PG8_WAIT_L(n) asm volatile("s_waitcnt lgkmcnt(" #n ")" ::: "memory")
#define PG8_BAR __builtin_amdgcn_s_barrier()
#define PG8_SCHED __builtin_amdgcn_sched_barrier(0)
    Unit cur, nxt; int ui = 0;
    if (!S.next(0, cur)) return;
    f32x4 acc[2][2][4][2];
#pragma unroll
    for (int a = 0; a < 2; ++a)
#pragma unroll
        for (int b = 0; b < 2; ++b)
#pragma unroll
            for (int m = 0; m < 4; ++m)
#pragma unroll
                for (int n = 0; n < 2; ++n) acc[a][b][m][n] = (f32x4){0.f, 0.f, 0.f, 0.f};
    bf16x8 At[4][2], B0[2][2], B1[2][2];
    const char* cA = cur.a; const char* cB = cur.b;
    PG8_STAGE(PG8_SB(0, 0), cB, voffB); PG8_STAGE(PG8_SB(0, 1), cB + hB, voffB); PG8_STAGE(PG8_SA(0, 0), cA, voffA); PG8_STAGE(PG8_SA(0, 1), cA + hA, voffA);
    if (wr == 1) PG8_BAR;
    PG8_WAIT_V(2); PG8_BAR;
    PG8_STAGE(PG8_SB(1, 0), cB + kB, voffB); PG8_STAGE(PG8_SA(1, 0), cA + kA, voffA); PG8_STAGE(PG8_SB(1, 1), cB + hB + kB, voffB);
    PG8_WAIT_V(6); PG8_BAR;
    for (;;) {
        const bool has_next = S.next(ui + 1, nxt);
        const char* nA = has_next ? nxt.a : cA; const char* nB = has_next ? nxt.b : cB;
        for (int t = 0; t < nt; t += 2) {
            const bool last = (t == nt - 2);
            const char* a1 = cA + (size_t)(t + 1) * kA;
            const char* a2 = last ? nA : cA + (size_t)(t + 2) * kA; const char* b2 = last ? nB : cB + (size_t)(t + 2) * kB;
            const char* a3 = a2 + kA; const char* b3 = b2 + kB;
            PG8_LDB(B0, 0, 0); PG8_LDB(B1, 0, 1); PG8_SCHED; PG8_LDA(At, 0, 0); PG8_STAGE(PG8_SA(1, 1), a1 + hA, voffA);
            PG8_WAIT_V(8); PG8_WAIT_L(0); PG8_BAR; PG8_MMA(0, 0, At, B0); PG8_MMA(0, 1, At, B1); PG8_BAR; PG8_SCHED;
            PG8_LDA(At, 0, 1); PG8_STAGE(PG8_SB(0, 0), b2, voffB); PG8_STAGE(PG8_SB(0, 1), b2 + hB, voffB); PG8_STAGE(PG8_SA(0, 0), a2, voffA);
            PG8_WAIT_V(8); PG8_WAIT_L(0); PG8_BAR; PG8_MMA(1, 0, At, B0); PG8_MMA(1, 1, At, B1); PG8_BAR; PG8_SCHED;
            PG8_LDB(B0, 1, 0); PG8_LDB(B1, 1, 1); PG8_SCHED; PG8_LDA(At, 1, 0); PG8_STAGE(PG8_SA(0, 1), a2 + hA, voffA);
            PG8_WAIT_V(8); PG8_WAIT_L(0); PG8_BAR; PG8_MMA(0, 0, At, B0); PG8_MMA(0, 1, At, B1); PG8_BAR; PG8_SCHED;
            PG8_LDA(At, 1, 1); PG8_STAGE(PG8_SB(1, 0), b3, voffB); PG8_STAGE(PG8_SB(1, 1), b3 + hB, voffB); PG8_STAGE(PG8_SA(1, 0), a3, voffA);
            PG8_WAIT_V(8); PG8_WAIT_L(0); PG8_BAR; PG8_MMA(1, 0, At, B0); PG8_MMA(1, 1, At, B1); PG8_BAR; PG8_SCHED;
        }
        if constexpr (ALIGN_EPI) { if (wr == 0) PG8_BAR; }
        E(acc, cur, wr, wc, fr, fq);
        if (!has_next) break;
#pragma unroll
        for (int a = 0; a < 2; ++a)
#pragma unroll
            for (int b = 0; b < 2; ++b)
#pragma unroll
                for (int m = 0; m < 4; ++m)
#pragma unroll
                    for (int n = 0; n < 2; ++n) acc[a][b][m][n] = (f32x4){0.f, 0.f, 0.f, 0.f};
        cur = nxt; cA = nA; cB = nB; ++ui;
        if constexpr (ALIGN_EPI) { if (wr == 1) PG8_BAR; }
    }
    PG8_WAIT_V(0);
    if constexpr (!ALIGN_EPI) { if (wr == 0) PG8_BAR; }
    PG8_BAR;
#undef PG8_SA
#undef PG8_SB
#undef PG8_STAGE
#undef PG8_LDA
#undef PG8_LDB
#undef PG8_MMA
#undef PG8_WAIT_V
#undef PG8_WAIT_L
#undef PG8_BAR
#undef PG8_SCHED
}
}
using pg8::Unit;
typedef f32x4 Acc[2][2][4][2];

DI void st8_bf16(bf16_t* p, f32x4 v0, f32x4 v1) { u32x4 w; w.x = cvtpk(v0[0], v0[1]); w.y = cvtpk(v0[2], v0[3]); w.z = cvtpk(v1[0], v1[1]); w.w = cvtpk(v1[2], v1[3]); *(u32x4*)p = w; }

struct SchedPlain {
    int nM, nN, G, c; const char* A; const char* B; size_t atile, btile;
    DI bool next(int i, Unit& u) const { int pm, pn; if (!pg8::order_next(nM, nN, G, c, i, pm, pn)) return false; u.pm = pm; u.pn = pn; u.a = A + (size_t)pm * atile; u.b = B + (size_t)pn * btile; return true; }
};
struct SchedU {
    int nM, nN, G, c; const char* A; const char* B; size_t atile, btile, agroup;
    DI bool next(int i, Unit& u) const { int pm, pn; if (!pg8::order_next(nM, nN, G, c, i, pm, pn)) return false; u.pm = pm; u.pn = pn; u.a = A + (size_t)(pn >> 1) * agroup + (size_t)pm * atile; u.b = B + (size_t)pn * btile; return true; }
};
struct SchedNsaA {
    int G, c; const char* A; const char* B;
    DI bool next(int i, Unit& u) const { int pm, pn; if (!pg8::order_next(MTOK / 256, 2, G, c, i, pm, pn)) return false; u.pm = pm; u.pn = pn + 4; u.a = A + (size_t)pm * (256 * 1024 * 2); u.b = B + (size_t)(pn + 4) * (256 * 1024 * 2); return true; }
};
struct SchedNsaB {
    int c; const char* A; const char* B;
    DI bool next(int i, Unit& u) const {
        int L;
        if (c < 64) { if (i >= 5) return false; L = i * 256 + c; }
        else if (c < 192) { if (i < 6) L = i * 256 + c; else if (i == 6) L = 1536 + (c - 64); else return false; }
        else { if (i < 6) L = i * 256 + c; else if (i == 6) L = 1280 + (c - 192); else return false; }
        int pm, pn; pg8::order_map(MTOK / 256, 13, L, pm, pn); pn = pn < 4 ? pn : pn + 2;
        u.pm = pm; u.pn = pn; u.a = A + (size_t)pm * (256 * 1024 * 2); u.b = B + (size_t)pn * (256 * 1024 * 2); return true; }
};
struct SchedZU {
    int G, c; const char* XBp; const char* XPp; const char* WZ; const char* WC;
    DI bool next(int i, Unit& u) const { int pm, pn; if (!pg8::order_next(MTOK / 256, 8, G, c, i >> 1, pm, pn)) return false; u.pm = pm;
        if ((i & 1) == 0) { u.pn = pn + 8; u.a = XBp + (size_t)pm * (256 * 1024 * 2); u.b = WZ + (size_t)pn * (256 * 1024 * 2); }
        else { u.pn = pn; u.a = XPp + (size_t)(pn >> 1) * ((size_t)MTOK * 1024 * 2) + (size_t)pm * (256 * 1024 * 2); u.b = WC + (size_t)pn * (256 * 1024 * 2); }
        return true; }
};
struct SchedWc {
    int G, c; const char* A; const char* B;
    DI bool next(int i, Unit& u) const { int pm, pn; if (!pg8::order_next(8, 4, G, c, i, pm, pn)) return false; u.pm = pm; u.pn = pn; u.a = A + (size_t)pm * (256 * 512 * 2); u.b = B + (size_t)pn * (256 * 2048 * 2) + (size_t)(pm >> 1) * 1024; return true; }
};
struct SchedCmp1 {
    int G, c; const char* KV; const char* W1;
    DI bool next(int i, Unit& u) const { int pm, pn; if (!pg8::order_next(64, 1, G, c, i, pm, pn)) return false; u.pm = pm; u.pn = 0;
        const int kv = pm >> 5, rt = pm & 31, b = rt >> 1, g0 = (rt & 1) * 2;
        u.a = KV + (size_t)kv * ((size_t)MTOK * 256 * 2) + ((size_t)b * SEQ * 256 + g0 * 64) * 2; u.b = W1 + (size_t)kv * (256 * 2048 * 2); return true; }
};
struct SchedCmp2 {
    int G, c; const char* H; const char* W2;
    DI bool next(int i, Unit& u) const { int pm, pn; if (!pg8::order_next(64, 1, G, c, i, pm, pn)) return false; u.pm = pm; u.pn = 0;
        u.a = H + (size_t)pm * (256 * 256 * 2); u.b = W2 + (size_t)(pm >> 5) * (256 * 256 * 2); return true; }
};

#define EPI_LOOP_ROWS for (int ai = 0; ai < 2; ++ai) for (int m = 0; m < 4; ++m)
struct EpiSilu {
    bf16_t* O; int ld;
    DI void operator()(const Acc& acc, const Unit& u, int wr, int wc, int fr, int fq) const {
        const int row0 = u.pm * 256 + wr * 64 + fr, col0 = u.pn * 256 + wc * 32 + 8 * fq;
#pragma unroll
        EPI_LOOP_ROWS { bf16_t* rp = O + (size_t)(row0 + ai * 128 + m * 16) * ld + col0;
#pragma unroll
            for (int bj = 0; bj < 2; ++bj) { f32x4 v0 = acc[ai][bj][m][0], v1 = acc[ai][bj][m][1];
#pragma unroll
                for (int e = 0; e < 4; ++e) { v0[e] = silu_f(v0[e]); v1[e] = silu_f(v1[e]); }
                st8_bf16(rp + bj * 128, v0, v1); } }
    }
};
struct EpiMulSz {
    bf16_t* O; const bf16_t* SZ; int ld;
    DI void operator()(const Acc& acc, const Unit& u, int wr, int wc, int fr, int fq) const {
        const int row0 = u.pm * 256 + wr * 64 + fr, col0 = u.pn * 256 + wc * 32 + 8 * fq;
#pragma unroll
        EPI_LOOP_ROWS { const size_t off = (size_t)(row0 + ai * 128 + m * 16) * ld + col0;
#pragma unroll
            for (int bj = 0; bj < 2; ++bj) { f32x4 v0 = acc[ai][bj][m][0], v1 = acc[ai][bj][m][1]; const u32x4 s = *(const u32x4*)(SZ + off + bj * 128);
                v0[0] *= bf_lo(s.x); v0[1] *= bf_hi(s.x); v0[2] *= bf_lo(s.y); v0[3] *= bf_hi(s.y); v1[0] *= bf_lo(s.z); v1[1] *= bf_hi(s.z); v1[2] *= bf_lo(s.w); v1[3] *= bf_hi(s.w);
                st8_bf16(O + off + bj * 128, v0, v1); } }
    }
};
DI void row_stats(const float* SF, int row, float& mean, float& rstd) { const f32x2 t = *(const f32x2*)(SF + (size_t)row * 2); mean = t[0]; rstd = t[1]; }
struct EpiZU {
    bf16_t* O; bf16_t* SZ;
    DI void operator()(const Acc& acc, const Unit& u, int wr, int wc, int fr, int fq) const {
        const bool isz = u.pn >= 8; const int rl0 = wr * 64 + fr, cl0 = wc * 32 + 8 * fq;
        if (isz) {
#pragma unroll
            EPI_LOOP_ROWS { bf16_t* rp = SZ + (size_t)(rl0 + ai * 128 + m * 16) * 256 + cl0;
#pragma unroll
                for (int bj = 0; bj < 2; ++bj) { f32x4 v0 = acc[ai][bj][m][0], v1 = acc[ai][bj][m][1];
#pragma unroll
                    for (int e = 0; e < 4; ++e) { v0[e] = silu_f(v0[e]); v1[e] = silu_f(v1[e]); }
                    st8_bf16(rp + bj * 128, v0, v1); } }
        } else {
            const int row0 = u.pm * 256 + rl0, col0 = u.pn * 256 + cl0;
            u32x4 zz[2][4][2];
#pragma unroll
            EPI_LOOP_ROWS {
#pragma unroll
                for (int bj = 0; bj < 2; ++bj) zz[ai][m][bj] = *(const u32x4*)(SZ + (size_t)(rl0 + ai * 128 + m * 16) * 256 + cl0 + bj * 128); }
            __builtin_amdgcn_sched_barrier(0);
#pragma unroll
            EPI_LOOP_ROWS { const size_t off = (size_t)(row0 + ai * 128 + m * 16) * 2048 + col0;
#pragma unroll
                for (int bj = 0; bj < 2; ++bj) { f32x4 v0 = acc[ai][bj][m][0], v1 = acc[ai][bj][m][1]; const u32x4 z = zz[ai][m][bj];
                    v0[0] *= bf_lo(z.x); v0[1] *= bf_hi(z.x); v0[2] *= bf_lo(z.y); v0[3] *= bf_hi(z.y); v1[0] *= bf_lo(z.z); v1[1] *= bf_hi(z.z); v1[2] *= bf_lo(z.w); v1[3] *= bf_hi(z.w);
                    st8_bf16(O + off + bj * 128, v0, v1); } }
        }
    }
};
struct EpiRes0 {
    float* O; bf16_t* OB; const float* R; float* ST;
    DI void operator()(const Acc& acc, const Unit& u, int wr, int wc, int fr, int fq) const {
        const int row0 = u.pm * 256 + wr * 64 + fr, col0 = u.pn * 256 + wc * 32 + 8 * fq;
#pragma unroll
        for (int ai = 0; ai < 2; ++ai) {
            f32x4 xr[4][2][2];
#pragma unroll
            for (int m = 0; m < 4; ++m)
#pragma unroll
                for (int bj = 0; bj < 2; ++bj) { const float* rp = R + (size_t)(row0 + ai * 128 + m * 16) * DM + col0 + bj * 128;
                    xr[m][bj][0] = __builtin_nontemporal_load((const f32x4*)rp); xr[m][bj][1] = __builtin_nontemporal_load((const f32x4*)(rp + 4)); }
            __builtin_amdgcn_sched_barrier(0);
#pragma unroll
            for (int m = 0; m < 4; ++m) { const int row = row0 + ai * 128 + m * 16; const size_t off = (size_t)row * DM + col0; float s = 0.f, q = 0.f;
#pragma unroll
                for (int bj = 0; bj < 2; ++bj) {
                    const f32x4 v0 = xr[m][bj][0] * DN_ALPHA + acc[ai][bj][m][0], v1 = xr[m][bj][1] * DN_ALPHA + acc[ai][bj][m][1];
                    __builtin_nontemporal_store(v0, (f32x4*)(O + off + bj * 128)); __builtin_nontemporal_store(v1, (f32x4*)(O + off + bj * 128 + 4)); st8_bf16(OB + off + bj * 128, v0, v1);
                    s += ((v0[0] + v0[1]) + (v0[2] + v0[3])) + ((v1[0] + v1[1]) + (v1[2] + v1[3]));
                    q += ((v0[0] * v0[0] + v0[1] * v0[1]) + (v0[2] * v0[2] + v0[3] * v0[3])) + ((v1[0] * v1[0] + v1[1] * v1[1]) + (v1[2] * v1[2] + v1[3] * v1[3])); }
                s += __shfl_xor(s, 16); q += __shfl_xor(q, 16); s += __shfl_xor(s, 32); q += __shfl_xor(q, 32);
                if (fq == 0) { f32x2 o = {s, q}; *(f32x2*)(ST + (size_t)row * 32 + (u.pn * 4 + wc) * 2) = o; } }
        }
    }
};
struct EpiBf16 {
    bf16_t* O;
    DI void operator()(const Acc& acc, const Unit& u, int wr, int wc, int fr, int fq) const {
        const int row0 = u.pm * 256 + wr * 64 + fr, col0 = u.pn * 256 + wc * 32 + 8 * fq;
#pragma unroll
        EPI_LOOP_ROWS { bf16_t* rp = O + (size_t)(row0 + ai * 128 + m * 16) * DM + col0;
#pragma unroll
            for (int bj = 0; bj < 2; ++bj) st8_bf16(rp + bj * 128, acc[ai][bj][m][0], acc[ai][bj][m][1]); }
    }
};
struct EpiRes1 {
    float* O; const float* V; const float* SF; const float* gam; const float* bet;
    DI void operator()(const Acc& acc, const Unit& u, int wr, int wc, int fr, int fq) const {
        const int row0 = u.pm * 256 + wr * 64 + fr, col0 = u.pn * 256 + wc * 32 + 8 * fq;
        f32x4 g[2][2], bt[2][2];
#pragma unroll
        for (int bj = 0; bj < 2; ++bj) { const int c = col0 + bj * 128; g[bj][0] = *(const f32x4*)(gam + c); g[bj][1] = *(const f32x4*)(gam + c + 4); bt[bj][0] = *(const f32x4*)(bet + c); bt[bj][1] = *(const f32x4*)(bet + c + 4); }
#pragma unroll
        EPI_LOOP_ROWS { const int row = row0 + ai * 128 + m * 16; float mean, rstd; row_stats(SF, row, mean, rstd);
#pragma unroll
            for (int bj = 0; bj < 2; ++bj) { const size_t off = (size_t)row * DM + col0 + bj * 128;
                const f32x4 r0 = *(const f32x4*)(V + off), r1 = *(const f32x4*)(V + off + 4);
                const f32x4 x0 = (r0 - mean) * rstd * g[bj][0] + bt[bj][0], x1 = (r1 - mean) * rstd * g[bj][1] + bt[bj][1];
                *(f32x4*)(O + off) = x0 * DN_ALPHA + acc[ai][bj][m][0]; *(f32x4*)(O + off + 4) = x1 * DN_ALPHA + acc[ai][bj][m][1]; } }
    }
};
struct EpiWc {
    bf16_t* O; const float* scale;
    DI void operator()(const Acc& acc, const Unit& u, int wr, int wc, int fr, int fq) const {
        const int row0 = u.pm * 256 + wr * 64 + fr, col0 = u.pn * 256 + wc * 32 + 8 * fq;
#pragma unroll
        EPI_LOOP_ROWS { const int row = row0 + ai * 128 + m * 16; const float sc = scale[row];
#pragma unroll
            for (int bj = 0; bj < 2; ++bj) st8_bf16(O + (size_t)row * 1024 + col0 + bj * 128, acc[ai][bj][m][0] * sc, acc[ai][bj][m][1] * sc); }
    }
};
struct EpiNsaIn {
    bf16_t* Q; bf16_t* KV; bf16_t* SZ; float* GT; const float* SF; const float* GB;
    DI void operator()(const Acc& acc, const Unit& u, int wr, int wc, int fr, int fq) const {
        const int row0 = u.pm * 256 + wr * 64 + fr, cl0 = wc * 32 + 8 * fq, pn = u.pn;
        if (pn == 14 && cl0 >= 48) return;
        f32x4 Gv[2][2], Bv[2][2];
#pragma unroll
        for (int bj = 0; bj < 2; ++bj) { const int c = pn * 256 + bj * 128 + cl0; Gv[bj][0] = *(const f32x4*)(GB + c); Gv[bj][1] = *(const f32x4*)(GB + c + 4); Bv[bj][0] = *(const f32x4*)(GB + NSA_PAD + c); Bv[bj][1] = *(const f32x4*)(GB + NSA_PAD + c + 4); }
        f32x2 stt[2][4];
#pragma unroll
        EPI_LOOP_ROWS stt[ai][m] = *(const f32x2*)(SF + (size_t)(row0 + ai * 128 + m * 16) * 2);
        __builtin_amdgcn_sched_barrier(0);
#pragma unroll
        EPI_LOOP_ROWS { const int row = row0 + ai * 128 + m * 16; const float mean = stt[ai][m][0], rstd = stt[ai][m][1];
#pragma unroll
            for (int bj = 0; bj < 2; ++bj) {
                if (pn == 14 && bj == 1) break;
                f32x4 v0 = (acc[ai][bj][m][0] - Gv[bj][0] * mean) * rstd + Bv[bj][0], v1 = (acc[ai][bj][m][1] - Gv[bj][1] * mean) * rstd + Bv[bj][1];
                if (pn < 4) { v0 = v0 * (0.125f * LOG2E); v1 = v1 * (0.125f * LOG2E); st8_bf16(Q + (size_t)row * 1024 + pn * 256 + bj * 128 + cl0, v0, v1); }
                else if (pn < 10) { st8_bf16(KV + (size_t)(pn - 4) * ((size_t)MTOK * 256) + (size_t)row * 256 + bj * 128 + cl0, v0, v1); }
                else if (pn < 14) {
#pragma unroll
                    for (int e = 0; e < 4; ++e) { v0[e] = silu_f(v0[e]); v1[e] = silu_f(v1[e]); }
                    st8_bf16(SZ + (size_t)row * 1024 + (pn - 10) * 256 + bj * 128 + cl0, v0, v1); }
                else {
#pragma unroll
                    for (int e = 0; e < 4; ++e) { v0[e] = sigmoid_f(v0[e]); v1[e] = sigmoid_f(v1[e]); }
                    float* rp = GT + (size_t)row * 48 + cl0; *(f32x4*)rp = v0; *(f32x4*)(rp + 4) = v1; } } }
    }
};
struct EpiHid {
    bf16_t* O; const float* bias;
    DI void operator()(const Acc& acc, const Unit& u, int wr, int wc, int fr, int fq) const {
        const int row0 = u.pm * 256 + wr * 64 + fr, col0 = wc * 32 + 8 * fq; const float* bp = bias + (u.pm >> 5) * 256 + col0;
#pragma unroll
        for (int bj = 0; bj < 2; ++bj) { const f32x4 b0 = *(const f32x4*)(bp + bj * 128), b1 = *(const f32x4*)(bp + bj * 128 + 4);
#pragma unroll
            EPI_LOOP_ROWS { f32x4 v0 = acc[ai][bj][m][0] + b0, v1 = acc[ai][bj][m][1] + b1;
#pragma unroll
                for (int e = 0; e < 4; ++e) { v0[e] = silu_f(v0[e]); v1[e] = silu_f(v1[e]); }
                st8_bf16(O + (size_t)(row0 + ai * 128 + m * 16) * 256 + col0 + bj * 128, v0, v1); } }
    }
};
struct EpiCmp {
    bf16_t* O;
    DI void operator()(const Acc& acc, const Unit& u, int wr, int wc, int fr, int fq) const {
        if (wc >= 2) return;
        const int row0 = u.pm * 256 + wr * 64 + fr, col0 = wc * 32 + 8 * fq;
#pragma unroll
        EPI_LOOP_ROWS { const int row = row0 + ai * 128 + m * 16; f32x4 v0 = acc[ai][0][m][0], v1 = acc[ai][0][m][1];
            if ((row & 127) == 127) { v0 = (f32x4){0.f, 0.f, 0.f, 0.f}; v1 = v0; }
            st8_bf16(O + (size_t)row * 64 + col0, v0, v1); }
    }
};


#define XB_TMO      128
#define XB_XCNT(j)  (256  + 64 * (j))
#define XB_XSUB(j)  (1280 + 64 * (j))
#define XB_XGEN(j)  (2304 + 64 * (j))
#define XB_TOP      3328
#define XB_TOPGEN   3392
#define XCD_BAR_WORDS 3456
#define XB_SPIN_CAP (1u << 22)
DI unsigned xb_ld(unsigned* p)              { return __hip_atomic_load(p, __ATOMIC_RELAXED, __HIP_MEMORY_SCOPE_AGENT); }
DI unsigned xb_add(unsigned* p, unsigned v) { return __hip_atomic_fetch_add(p, v, __ATOMIC_RELAXED, __HIP_MEMORY_SCOPE_AGENT); }
DI unsigned xb_xcc_id() { return (unsigned)__builtin_amdgcn_s_getreg((3 << 11) | 20) & 0xFu; }
#define XB_SPIN(cond, bar) do { unsigned _sp = 0; while (cond) { __builtin_amdgcn_s_sleep(1); \
    if ((++_sp & 255u) == 0u) { if (xb_ld(&(bar)[XB_TMO])) break; if (_sp > XB_SPIN_CAP) { atomicAdd(&(bar)[XB_TMO], 1u); break; } } } } while (0)
struct XcdBarrier { unsigned* bar; unsigned x; volatile LAS unsigned* st; };
DI XcdBarrier xcd_barrier_post(unsigned* bar, volatile LAS unsigned* st) {
    XcdBarrier b; b.bar = bar; b.x = xb_xcc_id(); b.st = st;
    if (threadIdx.x == 0) (void)xb_add(&bar[XB_XCNT(b.x)], 1u);
    return b;
}
DI void xcd_barrier_complete(unsigned* bar, unsigned x, unsigned& nloc, unsigned& nx) {
    const unsigned G = gridDim.x * gridDim.y * gridDim.z;
    unsigned sum, cnt, mine, sp = 0u;
    for (;;) {
        sum = 0u; cnt = 0u; mine = 0u;
#pragma unroll
        for (unsigned j = 0; j < 16; ++j) { const unsigned c = xb_ld(&bar[XB_XCNT(j)]); sum += c; cnt += (c > 0u) ? 1u : 0u; mine = (j == x) ? c : mine; }
        if (sum == G) break;
        __builtin_amdgcn_s_sleep(1);
        if ((++sp & 255u) == 0u) { if (xb_ld(&bar[XB_TMO])) break; if (sp > XB_SPIN_CAP) { atomicAdd(&bar[XB_TMO], 1u); break; } }
    }
    nloc = mine > 0u ? mine : 1u; nx = cnt > 0u ? cnt : 1u;
}
DI void xcd_barrier(const XcdBarrier& b) {
    asm volatile("s_waitcnt vmcnt(0)" ::: "memory");
    __syncthreads();
    if (threadIdx.x == 0) {
        unsigned* bar = b.bar;
        __builtin_amdgcn_s_waitcnt(0);
        unsigned nloc = b.st[0], nx = b.st[1];
        if (nloc == 0u) { xcd_barrier_complete(bar, b.x, nloc, nx); b.st[0] = nloc; b.st[1] = nx; }
        const unsigned old = xb_add(&bar[XB_XSUB(b.x)], 1u);
        const unsigned gen = old / nloc;
        if (old + 1u == (gen + 1u) * nloc) {
            __builtin_amdgcn_fence(__ATOMIC_RELEASE, "agent");
            asm volatile("s_waitcnt vmcnt(0)" ::: "memory");
            const unsigned og = xb_add(&bar[XB_TOP], 1u);
            const unsigned tg = og / nx;
            if (og + 1u == (tg + 1u) * nx) xb_add(&bar[XB_TOPGEN], 1u);
            else XB_SPIN(xb_ld(&bar[XB_TOPGEN]) == tg, bar);
            __builtin_amdgcn_fence(__ATOMIC_ACQUIRE, "agent");
            xb_add(&bar[XB_XGEN(b.x)], 1u);
            asm volatile("s_waitcnt vmcnt(0)" ::: "memory");
        } else {
            XB_SPIN(xb_ld(&bar[XB_XGEN(b.x)]) == gen, bar);
            __builtin_amdgcn_fence(__ATOMIC_ACQUIRE, "agent");
            asm volatile("s_waitcnt vmcnt(0)" ::: "memory");
        }
    }
    __syncthreads();
}

struct Args { const float* in[15]; float* out; unsigned char* ws; int ph_lo, ph_hi; };
enum { I_X = 0, I_LNG, I_LNB, I_PWIN, I_PWGRP, I_PSCALE, I_PWOUT, I_NWIN, I_POSK, I_W1K, I_W2K, I_POSV, I_W1V, I_W2V, I_NWOUT };

DI void transpose_item(const float* W, int ldw, int Nsrc, int Npad, bf16_t* WT, int ldt, LAS float* scr, int item, int lane, const float* rs = nullptr) {
    const int nblk = Npad / 32, kb = item / nblk, nb = item % nblk, k0 = 64 * kb, n0 = 32 * nb;
    const int nn = n0 + (lane & 31); const bool ok = nn < Nsrc;
#pragma unroll 8
    for (int i = 0; i < 32; ++i) { const int kk = 2 * i + (lane >> 5); scr[kk * 33 + (lane & 31)] = ok ? W[(size_t)(k0 + kk) * ldw + nn] * (rs ? rs[k0 + kk] : 1.f) : 0.f; }
    asm volatile("s_waitcnt lgkmcnt(0)" ::: "memory");
    const int c = lane & 7;
#pragma unroll
    for (int j = 0; j < 4; ++j) { const int n = (lane >> 3) + 8 * j; const LAS float* s = scr + (8 * c) * 33 + n;
        u32x4 o; o.x = cvtpk(s[0 * 33], s[1 * 33]); o.y = cvtpk(s[2 * 33], s[3 * 33]); o.z = cvtpk(s[4 * 33], s[5 * 33]); o.w = cvtpk(s[6 * 33], s[7 * 33]);
        *(u32x4*)(WT + (size_t)(n0 + n) * ldt + k0 + 8 * c) = o; }
    asm volatile("s_waitcnt lgkmcnt(0)" ::: "memory");
}

DI void phase_convert(const Args& a, LAS unsigned char* lds, int skip, bool with_wc_ops) {
    unsigned char* ws = a.ws;
    const int tid = threadIdx.x, lane = tid & 63, wave = __builtin_amdgcn_readfirstlane(tid >> 6);
    if ((int)blockIdx.x < skip) return;
    const int G = gridDim.x - skip, gw = ((int)blockIdx.x - skip) * 8 + wave, NGW = G * 8, bidc = (int)blockIdx.x - skip;
    LAS float* scr = (LAS float*)(lds + wave * 16384);
    constexpr int J0 = 16 * 64, J1 = 32 * 32, J2 = 16 * 120, J3 = 32 * 8, J5 = 4 * 8, J7 = 16 * 32, J8 = 8 * 16;
    constexpr int NIT0 = J0 + J1 + J2 + 2 * J3 + 2 * J5 + J7;
    const int NIT = NIT0 + (with_wc_ops ? 4 * J8 : 0);
    for (int it = gw; it < NIT; it += NGW) {
        int r = it;
        if (r < J0) { transpose_item(a.in[I_PWIN] + 2048, 4096, 2048, 2048, (bf16_t*)(ws + WS_WZT), 1024, scr, r, lane); continue; } r -= J0;
        if (r < J1) { transpose_item(a.in[I_PWOUT], 1024, 1024, 1024, (bf16_t*)(ws + WS_WPOT), 2048, scr, r, lane); continue; } r -= J1;
        if (r < J2) { transpose_item(a.in[I_NWIN], NSA_IN, NSA_IN, NSA_PAD, (bf16_t*)(ws + WS_WNIT), 1024, scr, r, lane, a.in[I_LNG]); continue; } r -= J2;
        if (r < J3) { transpose_item(a.in[I_W1K], 256, 256, 256, (bf16_t*)(ws + WS_W1T), 2048, scr, r, lane); continue; } r -= J3;
        if (r < J3) { transpose_item(a.in[I_W1V], 256, 256, 256, (bf16_t*)(ws + WS_W1T) + 256 * 2048, 2048, scr, r, lane); continue; } r -= J3;
        if (r < J5) { transpose_item(a.in[I_W2K], 64, 64, 256, (bf16_t*)(ws + WS_W2T), 256, scr, r, lane); continue; } r -= J5;
        if (r < J5) { transpose_item(a.in[I_W2V], 64, 64, 256, (bf16_t*)(ws + WS_W2T) + 256 * 256, 256, scr, r, lane); continue; } r -= J5;
        if (r < J7) { transpose_item(a.in[I_NWOUT], 1024, 1024, 1024, (bf16_t*)(ws + WS_WNOT), 1024, scr, r, lane); continue; } r -= J7;
        { const int g = r / J8; r -= g * J8; transpose_item(a.in[I_PWGRP] + (size_t)g * 512 * 512, 512, 512, 512, (bf16_t*)(ws + WS_WGT) + (size_t)g * 512 * 512, 512, scr, r, lane); }
    }
    { const float* W = a.in[I_PWIN]; bf16_t* O = (bf16_t*)(ws + WS_WINB);
      if (with_wc_ops) for (int e = bidc * 512 + tid; e < 1024 * 512; e += G * 512) { const int k = e >> 9, c4 = (e & 511) * 4; const f32x4 v = *(const f32x4*)(W + (size_t)k * 4096 + c4);
          u32x2 o; o.x = cvtpk(v[0], v[1]); o.y = cvtpk(v[2], v[3]); *(u32x2*)(O + (size_t)k * 2048 + c4) = o; } }
    for (int wi = gw; wi < (NSA_PAD / 64) * 32; wi += NGW) {
        const int chunk = wi % (NSA_PAD / 64), ks = wi / (NSA_PAD / 64), c = chunk * 64 + lane;
        const float* W = a.in[I_NWIN]; const float* gam = a.in[I_LNG]; const float* bet = a.in[I_LNB];
        float sg = 0.f, sb = 0.f;
        if (c < NSA_IN) {
#pragma unroll
            for (int j = 0; j < 32; ++j) { const int k = ks * 32 + j; const float wv = W[(size_t)k * NSA_IN + c]; sg += gam[k] * wv; sb += bet[k] * wv; } }
        float* part = (float*)(ws + WS_PART); part[(size_t)(ks * 2) * NSA_PAD + c] = sg; part[(size_t)(ks * 2 + 1) * NSA_PAD + c] = sb;
    }
    for (int wi = gw; wi < 64; wi += NGW) {
        const int kv = wi >> 5, n0 = (wi & 31) * 8, kk = lane >> 3, nn = lane & 7;
        const float* pos = a.in[kv ? I_POSV : I_POSK]; const float* w1 = a.in[kv ? I_W1V : I_W1K];
        float s = 0.f;
        for (int j = 0; j < 256; ++j) { const int k = kk + 8 * j; s += pos[k] * w1[(size_t)k * 256 + n0 + nn]; }
        s += __shfl_xor(s, 8); s += __shfl_xor(s, 16); s += __shfl_xor(s, 32);
        if (lane < 8) ((float*)(ws + WS_BIAS))[kv * 256 + n0 + nn] = s;
    }
}

struct SchedOne { const char* A; const char* B; int pm, pn; DI bool next(int i, Unit& u) const { if (i) return false; u.pm = pm; u.pn = pn; u.a = A; u.b = B; return true; } };
DI void wc_unit(const Args& a, LAS unsigned char* lds, int unit) {
    const int tid = threadIdx.x, lane = tid & 63, wave = __builtin_amdgcn_readfirstlane(tid >> 6);
    const int pm = unit >> 2, pn = unit & 3, g = pm >> 1, d0 = (pm & 1) * 256, k0 = pn * 256;
    bf16_t* Ap = (bf16_t*)(a.ws + WS_A) + (size_t)unit * (2 * 256 * 512);
    bf16_t* Bp = Ap + 256 * 512;
    LAS float* scr = (LAS float*)(lds + wave * 16384);
    for (int it = wave; it < 8 * 8; it += 8) transpose_item(a.in[I_PWGRP] + (size_t)g * 512 * 512 + d0, 512, 256, 256, Ap, 512, scr, it, lane);
    { const float* W = a.in[I_PWIN] + (size_t)k0 * 4096 + g * 512;
      for (int e = tid; e < 256 * 128; e += 512) { const int k = e >> 7, c4 = (e & 127) * 4; const f32x4 v = *(const f32x4*)(W + (size_t)k * 4096 + c4);
          u32x2 o; o.x = cvtpk(v[0], v[1]); o.y = cvtpk(v[2], v[3]); *(u32x2*)(Bp + (size_t)k * 512 + c4) = o; } }
    asm volatile("s_waitcnt vmcnt(0) lgkmcnt(0)" ::: "memory"); __syncthreads();
    const pg8::Geom gm{512, 512, 512, 128, 128, 128 * 512 * 2, 128 * 512 * 2};
    SchedOne S{(const char*)Ap, (const char*)Bp, pm, pn};
    EpiWc E{(bf16_t*)(a.ws + WS_WCT), a.in[I_PSCALE]};
    pg8::gemm_phase<EpiWc, SchedOne, false>(lds, gm, S, E);
}

#define POOL_LOAD(ARR, ROW0, GUARD) _Pragma("unroll") for (int j_ = 0; j_ < 8; ++j_) { ARR[j_] = (GUARD) ? __builtin_nontemporal_load((const f32x4*)(xp + (ptrdiff_t)((ROW0) + j_) * DM)) : (f32x4){0.f, 0.f, 0.f, 0.f}; }
#define POOL_INV(W, TL) ((edge_ && (TL) + 1 < (W)) ? 1.f / (float)((TL) + 1) : 1.f / (float)(W))
#define POOL_ST(PTR, V) { const f32x4 m_ = (V); u32x2 o_; o_.x = cvtpk(m_[0], m_[1]); o_.y = cvtpk(m_[2], m_[3]); __builtin_nontemporal_store(o_, (u32x2*)(PTR)); }
#define POOL_PROC(H0, H1, C, ROW0) { \
    _Pragma("unroll") for (int j_ = 0; j_ < 8; ++j_) { \
        const f32x4 x_ = C[j_]; const f32x4 p1_ = j_ >= 1 ? C[j_ >= 1 ? j_ - 1 : 0] : H1[7]; \
        const f32x4 W2 = p1_ + x_, W4 = S4 + x_, W8 = S8 + x_, W16 = S16 + x_; \
        const int tl_ = (ROW0) + j_; const size_t off_ = (size_t)(t0 + tl_) * DM + c4; \
        POOL_ST(XB + off_, x_) \
        POOL_ST(XP + off_, W2 * POOL_INV(2, tl_) - x_) \
        POOL_ST(XP + (size_t)MTOK * DM + off_, W4 * POOL_INV(4, tl_) - x_) \
        POOL_ST(XP + (size_t)2 * MTOK * DM + off_, W8 * POOL_INV(8, tl_) - x_) \
        POOL_ST(XP + (size_t)3 * MTOK * DM + off_, W16 * POOL_INV(16, tl_) - x_) \
        S4 = W4 - (j_ >= 3 ? C[j_ >= 3 ? j_ - 3 : 0] : H1[j_ < 3 ? j_ + 5 : 0]); S8 = W8 - (j_ >= 7 ? C[0] : H1[j_ < 7 ? j_ + 1 : 0]); S16 = W16 - (j_ >= 7 ? H1[0] : H0[j_ < 7 ? j_ + 1 : 0]); } }
DI void phase_pool(const Args& a, int blk, int nblk) {
    const float* X = a.in[I_X]; bf16_t* XB = (bf16_t*)(a.ws + WS_XB); bf16_t* XP = (bf16_t*)(a.ws + WS_XP);
    const int nitems = (MTOK / 64) * 256;
    for (int it = blk * 512 + (int)threadIdx.x; it < nitems; it += nblk * 512) {
        const int chunk = it >> 8, c4 = (it & 255) * 4, t0 = chunk * 64, tl0 = t0 & (SEQ - 1);
        const bool edge_ = tl0 == 0;
        const float* xp = X + (size_t)t0 * DM + c4;
        f32x4 A[8], B[8], C[8], D[8];
        POOL_LOAD(A, -16, !edge_)
        POOL_LOAD(B, -8, !edge_)
        POOL_LOAD(C, 0, true)
        POOL_LOAD(D, 8, true)
        f32x4 S16 = A[1], S8 = B[1], S4 = B[5] + B[6] + B[7];
#pragma unroll
        for (int j = 2; j < 8; ++j) { S16 = S16 + A[j]; S8 = S8 + B[j]; }
        S16 = S16 + B[0] + S8;
        POOL_PROC(A, B, C, 0)  POOL_LOAD(A, 16, true)
        POOL_PROC(B, C, D, 8)  POOL_LOAD(B, 24, true)
        POOL_PROC(C, D, A, 16) POOL_LOAD(C, 32, true)
        POOL_PROC(D, A, B, 24) POOL_LOAD(D, 40, true)
        POOL_PROC(A, B, C, 32) POOL_LOAD(A, 48, true)
        POOL_PROC(B, C, D, 40) POOL_LOAD(B, 56, true)
        POOL_PROC(C, D, A, 48)
        POOL_PROC(D, A, B, 56)
    }
}
#undef POOL_LOAD
#undef POOL_INV
#undef POOL_ST
#undef POOL_PROC

DI void phase_ln(const float* V, float* O, bf16_t* OB, const float* gam, const float* bet) {
    const int lane = threadIdx.x & 63, wave = threadIdx.x >> 6; const int gw = blockIdx.x * 8 + wave, NGW = gridDim.x * 8;
    f32x4 gg[4], bb[4];
#pragma unroll
    for (int j = 0; j < 4; ++j) { gg[j] = *(const f32x4*)(gam + 4 * lane + 256 * j); bb[j] = *(const f32x4*)(bet + 4 * lane + 256 * j); }
    for (int m = gw; m < MTOK; m += NGW) {
        const float* vr = V + (size_t)m * DM + 4 * lane; f32x4 v[4]; float s = 0.f;
#pragma unroll
        for (int j = 0; j < 4; ++j) { v[j] = *(const f32x4*)(vr + 256 * j); s += (v[j][0] + v[j][1]) + (v[j][2] + v[j][3]); }
        const float mean = wave_sum(s) * (1.f / DM); float s2 = 0.f;
#pragma unroll
        for (int j = 0; j < 4; ++j) { v[j] = v[j] - mean; s2 += (v[j][0] * v[j][0] + v[j][1] * v[j][1]) + (v[j][2] * v[j][2] + v[j][3] * v[j][3]); }
        const float rstd = 1.f / sqrtf(wave_sum(s2) * (1.f / DM) + LN_EPS);
#pragma unroll
        for (int j = 0; j < 4; ++j) { const f32x4 y = v[j] * rstd * gg[j] + bb[j]; *(f32x4*)(O + (size_t)m * DM + 4 * lane + 256 * j) = y;
            if (OB) { u32x2 o; o.x = cvtpk(y[0], y[1]); o.y = cvtpk(y[2], y[3]); *(u32x2*)(OB + (size_t)m * DM + 4 * lane + 256 * j) = o; } }
    }
}

DI void phase_final(const float* V, const float* SF, const bf16_t* Y1, float* O, const float* gam, const float* bet) {
    const int lane = threadIdx.x & 63, wave = threadIdx.x >> 6; const int gw = blockIdx.x * 8 + wave, NGW = gridDim.x * 8;
    f32x4 g0[4], b0[4], g1[4], b1[4];
#pragma unroll
    for (int j = 0; j < 4; ++j) { const int c = 4 * lane + 256 * j; g0[j] = *(const f32x4*)(gam + c); b0[j] = *(const f32x4*)(bet + c); g1[j] = *(const f32x4*)(gam + DM + c); b1[j] = *(const f32x4*)(bet + DM + c); }
    for (int m = gw; m < MTOK; m += NGW) {
        float mean0, rstd0; row_stats(SF, m, mean0, rstd0);
        f32x4 v[4]; float s = 0.f;
#pragma unroll
        for (int j = 0; j < 4; ++j) { const size_t off = (size_t)m * DM + 4 * lane + 256 * j; const f32x4 t = __builtin_nontemporal_load((const f32x4*)(V + off)); const u32x2 y = __builtin_nontemporal_load((const u32x2*)(Y1 + off));
            const f32x4 x1 = (t - mean0) * rstd0 * g0[j] + b0[j]; const f32x4 yv = {bf_lo(y.x), bf_hi(y.x), bf_lo(y.y), bf_hi(y.y)};
            v[j] = x1 * DN_ALPHA + yv; s += (v[j][0] + v[j][1]) + (v[j][2] + v[j][3]); }
        const float mean = wave_sum(s) * (1.f / DM); float s2 = 0.f;
#pragma unroll
        for (int j = 0; j < 4; ++j) { v[j] = v[j] - mean; s2 += (v[j][0] * v[j][0] + v[j][1] * v[j][1]) + (v[j][2] * v[j][2] + v[j][3] * v[j][3]); }
        const float rstd = 1.f / sqrtf(wave_sum(s2) * (1.f / DM) + LN_EPS);
#pragma unroll
        for (int j = 0; j < 4; ++j) __builtin_nontemporal_store(v[j] * rstd * g1[j] + b1[j], (f32x4*)(O + (size_t)m * DM + 4 * lane + 256 * j));
    }
}

constexpr int A_KT = 0, A_KT_SZ = 8192;
constexpr int A_VT = 3 * A_KT_SZ, A_VT_SZ = 8192;
constexpr int A_KC = A_VT + 3 * A_VT_SZ;
constexpr int A_VC = A_KC + 16384;
constexpr int A_IMP = 86016;
constexpr int A_TOT = A_IMP + 4 * 64 * 33 * 4;
constexpr int A_SEL = A_TOT + 8192;
constexpr int A_GATE = 132096;
static_assert(A_VC + 16384 <= A_IMP && A_SEL + 512 <= 131072 && A_GATE + 4096 <= 147456, "attention LDS map");
typedef short v4i16_t __attribute__((ext_vector_type(4)));
constexpr int NEGBITS = (int)0xF149F2CAu;
DI int crow(int i, int h) { return (i & 3) + 8 * (i >> 2) + 4 * h; }
DI bf16x8 pack8(const f32x16& x, int s) { u32x4 p; p.x = cvtpk(x[8 * s], x[8 * s + 1]); p.y = cvtpk(x[8 * s + 2], x[8 * s + 3]); p.z = cvtpk(x[8 * s + 4], x[8 * s + 5]); p.w = cvtpk(x[8 * s + 6], x[8 * s + 7]); return __builtin_bit_cast(bf16x8, p); }

DI void qk_tile(const LAS unsigned char* kb_, const bf16x8 (&qf)[4], const f32x16& AK, f32x16 (&S)[2], int r, int h) {
    const int kx = (r >> 1) & 7;
#pragma unroll
    for (int kb = 0; kb < 2; ++kb) {
#pragma unroll
        for (int s = 0; s < 4; ++s) { const bf16x8 kf = *(const LAS bf16x8*)(kb_ + (kb * 32 + r) * 128 + (((2 * s + h) ^ kx) << 4)); S[kb] = MFMA32(kf, qf[s], s == 0 ? AK : S[kb]); }
    }
}
DI void sm_pv_tile(f32x16 (&S)[2], const LAS unsigned char* vb_, f32x16 (&O)[2], float& mrun, float& lrun,
                   int kind, int n, int i, int tq, int qv, float slope2, unsigned selm, const int (&voff)[2][2],
                   bool do_qk, const LAS unsigned char* kn_, const bf16x8 (&qf)[4], const f32x16& AK, f32x16 (&SN)[2], int r, int h) {
    if (n == i || (kind == 0 && n == i - 4)) {
        const int flip = (n == i) ? 0 : -1;
#pragma unroll
        for (int kb = 0; kb < 2; ++kb)
#pragma unroll
            for (int e = 0; e < 16; ++e) { const int v = qv - (32 * kb + crow(e, 0)); S[kb][e] += __builtin_bit_cast(float, ((v ^ flip) >> 31) & NEGBITS); }
    }
    float mx0 = S[0][0], mx1 = S[1][0];
#pragma unroll
    for (int e = 1; e < 16; ++e) { mx0 = fmaxf(mx0, S[0][e]); mx1 = fmaxf(mx1, S[1][e]); }
    const float c32 = 32.f * slope2;
    float mx = fmaxf(mx0, mx1 + c32);
    mx = fmaxf(mx, __shfl_xor(mx, 32));
    const float ct = slope2 * (float)(tq - 64 * n);
    const bool qsel = kind ? ((selm >> n) & 1u) != 0u : true;
    const float mxt = qsel ? mx - ct : -1e30f;
    const bool need = mxt > mrun + 8.f;
    if (__ballot(need) != 0ull) {
        const float mnew = need ? mxt : mrun, alpha = fexp2(mrun - mnew); mrun = mnew; lrun *= alpha;
        O[0] = O[0] * alpha; O[1] = O[1] * alpha;
    }
    const float off = qsel ? mrun + ct : 1e30f;
    qk_tile(kn_, qf, AK, SN, r, h);
    float ls = 0.f;
#pragma unroll
    for (int kb = 0; kb < 2; ++kb)
#pragma unroll
        for (int e = 0; e < 16; ++e) { const float p = fexp2(S[kb][e] - (kb ? off - c32 : off)); S[kb][e] = p; ls += p; }
    lrun += ls;
#pragma unroll
    for (int kb = 0; kb < 2; ++kb)
#pragma unroll
        for (int s2 = 0; s2 < 2; ++s2) { const bf16x8 pb = pack8(S[kb], s2);
#pragma unroll
            for (int dt = 0; dt < 2; ++dt) { const LAS unsigned char* vp = vb_ + (32 * kb + 16 * s2) * 128;
                const s16x4 lo = __builtin_bit_cast(s16x4, __builtin_amdgcn_ds_read_tr16_b64_v4i16((LAS v4i16_t*)(vp + voff[dt][0])));
                const s16x4 hi = __builtin_bit_cast(s16x4, __builtin_amdgcn_ds_read_tr16_b64_v4i16((LAS v4i16_t*)(vp + voff[dt][1])));
                const bf16x8 vf = __builtin_shufflevector(lo, hi, 0, 1, 2, 3, 4, 5, 6, 7); O[dt] = MFMA32(vf, pb, O[dt]); } }
}
DI void tile_dma2(LAS unsigned char* dstK, LAS unsigned char* dstV, const bf16_t* Ksrc, const bf16_t* Vsrc, size_t base, int pitch, int w, int lane) {
    const int row = w * 8 + (lane >> 3), c = (lane & 7) ^ ((row >> 1) & 7);
    const size_t goff = base + (size_t)row * pitch + c * 8;
    __builtin_amdgcn_global_load_lds((const unsigned*)(Ksrc + goff), (LAS unsigned*)(dstK + w * 1024), 16, 0, 0);
    __builtin_amdgcn_global_load_lds((const unsigned*)(Vsrc + goff), (LAS unsigned*)(dstV + w * 1024), 16, 0, 0);
}
DI void cmp_dma(LAS unsigned char* lds, const bf16_t* CMP, int b, int g, int w, int lane) {
    const size_t base = (size_t)((b * 4 + g) * 128) * 64; const bf16_t* vc = CMP + (size_t)8192 * 64;
    tile_dma2(lds + A_KC, lds + A_VC, CMP, vc, base, 64, w, lane);
    tile_dma2(lds + A_KC + 8192, lds + A_VC + 8192, CMP, vc, base + 64 * 64, 64, w, lane);
}
DI void tile_dma(LAS unsigned char* lds, int bufi, const bf16_t* Ksrc, const bf16_t* Vsrc, size_t base, int w, int lane) {
    const int row = w * 8 + (lane >> 3), c = (lane & 7) ^ ((row >> 1) & 7);
    const size_t goff = base + (size_t)row * 256 + c * 8;
    __builtin_amdgcn_global_load_lds((const unsigned*)(Ksrc + goff), (LAS unsigned*)(lds + A_KT + bufi * A_KT_SZ + w * 1024), 16, 0, 0);
    __builtin_amdgcn_global_load_lds((const unsigned*)(Vsrc + goff), (LAS unsigned*)(lds + A_VT + bufi * A_VT_SZ + w * 1024), 16, 0, 0);
}

DI void attn_item(LAS unsigned char* lds, const bf16_t* QB, const bf16_t* KV, const bf16_t* CMP, const bf16_t* SZN, const float* GT, bf16_t* AO, int b, int i, int g, bool first, bool has_nx, int nxb, int nxg) {
    int tid_ = threadIdx.x; asm volatile("" : "+v"(tid_));
    const int tid = tid_, lane = tid & 63, w = __builtin_amdgcn_readfirstlane(tid >> 6), hh = w >> 1, qh = w & 1, r = lane & 31, h = lane >> 5;
    const int ql = 32 * qh + r, tq = 64 * i + ql, head = 4 * g + hh;
    const size_t row = (size_t)b * SEQ + tq;
    const bf16_t* KS = KV + (size_t)2 * MTOK * 256; const bf16_t* VS = KV + (size_t)3 * MTOK * 256;
    const bf16_t* KW = KV + (size_t)4 * MTOK * 256; const bf16_t* VW = KV + (size_t)5 * MTOK * 256;
    if (first) cmp_dma(lds, CMP, b, g, w, lane);
    if (tid == 0) ((LAS unsigned*)(lds + A_SEL))[64] = 0u;
    int voff[2][2];
    { const int q_ = (lane & 15) >> 2, p_ = lane & 3, blk_ = (lane >> 4) & 1, x_ = 2 * h + (q_ >> 1);
#pragma unroll
      for (int dt = 0; dt < 2; ++dt)
#pragma unroll
          for (int hi = 0; hi < 2; ++hi) voff[dt][hi] = (4 * h + q_ + 8 * hi) * 128 + (((4 * dt + 2 * blk_ + (p_ >> 1)) ^ (x_ ^ (4 * hi))) << 4) + (p_ & 1) * 8; }
    bf16x8 qf[4];
    { const bf16_t* qp = QB + row * 1024 + head * 64 + 8 * h;
#pragma unroll
      for (int s = 0; s < 4; ++s) qf[s] = *(const bf16x8*)(qp + 16 * s); }
    const float* gp = GT + row * 48 + head * 3; const float g0 = gp[0];
    { f32x2 g12 = {gp[1], gp[2]}; *(LAS f32x2*)(lds + A_GATE + tid * 8) = g12; }
    const float slope2 = fexp2(-0.5f * (float)(head + 1)) * LOG2E;
    __syncthreads();
    const size_t tbase = ((size_t)b * SEQ) * 256 + g * 64;
    tile_dma(lds, 0, KW, VW, tbase + (size_t)(64 * i) * 256, w, lane);
    if (i > 0) tile_dma(lds, 1, KW, VW, tbase + (size_t)(64 * (i - 1)) * 256, w, lane); else tile_dma(lds, 1, KS, VS, tbase, w, lane);
    f32x16 Oacc[2];
    {
        const int nkb = (i >> 3) + 1;
        f32x16 S[4];
        float mx = -1e30f;
#pragma unroll
        for (int kb = 0; kb < 4; ++kb) {
#pragma unroll
            for (int e = 0; e < 16; ++e) S[kb][e] = 0.f;
            if (kb < nkb) {
#pragma unroll
                for (int s = 0; s < 4; ++s) { const bf16x8 kf = *(const LAS bf16x8*)(lds + A_KC + (kb >> 1) * 8192 + ((kb & 1) * 32 + r) * 128 + (((2 * s + h) ^ ((r >> 1) & 7)) << 4)); S[kb] = MFMA32(kf, qf[s], S[kb]); }
#pragma unroll
                for (int e = 0; e < 16; ++e) { const int c = 32 * kb + crow(e, h); const int dist = tq - (16 * c + 31); const float sv = S[kb][e] - slope2 * (float)dist;
                    S[kb][e] = sv + __builtin_bit_cast(float, (dist >> 31) & NEGBITS); mx = fmaxf(mx, S[kb][e]); }
            }
        }
        mx = fmaxf(fmaxf(mx, __shfl_xor(mx, 32)), -1e20f);
        float l = 0.f;
#pragma unroll
        for (int kb = 0; kb < 4; ++kb) if (kb < nkb) {
#pragma unroll
            for (int e = 0; e < 16; ++e) { const float p = fexp2(S[kb][e] - mx); S[kb][e] = p; l += p; } }
        l += __shfl_xor(l, 32);
        const float inv = l > 0.f ? 1.f / l : 0.f;
        LAS float* imp = (LAS float*)(lds + A_IMP) + (hh * 64 + ql) * 33;
        float carry = 0.f;
#pragma unroll
        for (int kb = 0; kb < 4; ++kb) {
            if (kb < nkb) { S[kb] = S[kb] * inv;
#pragma unroll
                for (int ig = 0; ig < 4; ++ig) { const float gsum = (S[kb][4 * ig] + S[kb][4 * ig + 1]) + (S[kb][4 * ig + 2] + S[kb][4 * ig + 3]); const float plv = __shfl_xor(S[kb][4 * ig + 3], 32);
                    imp[8 * kb + 2 * ig + h] = gsum + (h ? plv : carry); carry = plv; } }
            else {
#pragma unroll
                for (int ig = 0; ig < 4; ++ig) { imp[8 * kb + 2 * ig + h] = (h == 0 && ig == 0) ? carry : 0.f; if (ig == 0) carry = 0.f; } } }
        f32x16 O[2];
#pragma unroll
        for (int dt = 0; dt < 2; ++dt)
#pragma unroll
            for (int e = 0; e < 16; ++e) O[dt][e] = 0.f;
#pragma unroll
        for (int kb = 0; kb < 4; ++kb) if (kb < nkb) {
#pragma unroll
            for (int s2 = 0; s2 < 2; ++s2) { const bf16x8 pb = pack8(S[kb], s2);
#pragma unroll
                for (int dt = 0; dt < 2; ++dt) { const LAS unsigned char* vp = lds + A_VC + (kb >> 1) * 8192 + ((kb & 1) * 32 + 16 * s2) * 128;
                    const s16x4 lo = __builtin_bit_cast(s16x4, __builtin_amdgcn_ds_read_tr16_b64_v4i16((LAS v4i16_t*)(vp + voff[dt][0])));
                    const s16x4 hi = __builtin_bit_cast(s16x4, __builtin_amdgcn_ds_read_tr16_b64_v4i16((LAS v4i16_t*)(vp + voff[dt][1])));
                    const bf16x8 vf = __builtin_shufflevector(lo, hi, 0, 1, 2, 3, 4, 5, 6, 7); O[dt] = MFMA32(vf, pb, O[dt]); } } }
        Oacc[0] = O[0] * g0; Oacc[1] = O[1] * g0;
    }
#define LBAR() do { asm volatile("s_waitcnt lgkmcnt(0)" ::: "memory"); __builtin_amdgcn_s_barrier(); } while (0)
    LBAR();
    if (has_nx) cmp_dma(lds, CMP, nxb, nxg, w, lane);
    {
        LAS float* IMP = (LAS float*)(lds + A_IMP); LAS float* TOT = (LAS float*)(lds + A_TOT); LAS unsigned* SEL = (LAS unsigned*)(lds + A_SEL);
        const int n = tid & 31;
#pragma unroll
        for (int ps = 0; ps < 4; ++ps) { const int q = ps * 16 + (tid >> 5);
            float v = (IMP[(0 * 64 + q) * 33 + n] + IMP[(1 * 64 + q) * 33 + n]) + (IMP[(2 * 64 + q) * 33 + n] + IMP[(3 * 64 + q) * 33 + n]);
            if (n == 0 || n == i || n == i - 1) v = 1e9f; else if (n > i) v = -1e30f;
            TOT[q * 32 + n] = v; }
        LBAR();
        unsigned uni = 0u;
#pragma unroll
        for (int ps = 0; ps < 4; ++ps) { const int q = ps * 16 + (tid >> 5); const float my = TOT[q * 32 + n]; int rank = 0;
#pragma unroll
            for (int j = 0; j < 8; ++j) { if (4 * j > i) break;
                const f32x4 t4 = *(const LAS f32x4*)(TOT + q * 32 + 4 * j);
#pragma unroll
                for (int e = 0; e < 4; ++e) { const int n2 = 4 * j + e; rank += (t4[e] > my || (t4[e] == my && n2 < n)) ? 1 : 0; } }
            const unsigned long long bal = __ballot(rank < 8);
            const unsigned lo = (unsigned)bal, hi = (unsigned)(bal >> 32);
            if (lane == 0) SEL[q] = lo; if (lane == 32) SEL[q] = hi;
            uni |= lo | hi; }
        const unsigned allowed = (i >= 31) ? 0xffffffffu : ((2u << i) - 1u);
        if (lane == 0) atomicOr((unsigned*)(SEL + 64), uni & allowed);
        LBAR();
    }
#undef LBAR
    const unsigned uni = __builtin_amdgcn_readfirstlane(((LAS unsigned*)(lds + A_SEL))[64]);
    const unsigned selm = ((LAS unsigned*)(lds + A_SEL))[ql];
    f32x16 AK;
#pragma unroll
    for (int e = 0; e < 16; ++e) AK[e] = slope2 * (float)crow(e, h);
    const int nlo = i - 4 < 0 ? 0 : i - 4;
    float mrun = -1e20f, lrun = 0.f; f32x16 O[2];
#pragma unroll
    for (int dt = 0; dt < 2; ++dt)
#pragma unroll
        for (int e = 0; e < 16; ++e) O[dt][e] = 0.f;
    const int qv = ql - 4 * h;
    int ck = 0, cn = i;
    int k1, n1; bool ok1 = true;
    if (cn > nlo) { k1 = 0; n1 = cn - 1; } else { k1 = 1; n1 = 31 - __builtin_clz(uni); }
    int k2 = k1, n2 = 0; bool ok2 = true;
#define TS_ADV(kk, nn, okk, ko, no, oko) do { ko = kk; no = 0; oko = okk; if (okk) { if (kk == 0) { if (nn > nlo) no = nn - 1; else { ko = 1; no = 31 - __builtin_clz(uni); } } \
        else { const unsigned rem_ = uni & ((1u << nn) - 1u); if (rem_ == 0u) oko = false; else no = 31 - __builtin_clz(rem_); } } } while (0)
    TS_ADV(k1, n1, ok1, k2, n2, ok2);
    int bc = 0;
    f32x16 Sa[2], Sb[2];
    asm volatile("s_waitcnt vmcnt(0)" ::: "memory"); __builtin_amdgcn_s_barrier();
    qk_tile(lds + A_KT, qf, AK, Sa, r, h);
#define TILE_STEP(SC, SN) { \
        asm volatile("s_waitcnt vmcnt(0)" ::: "memory");        \
        __builtin_amdgcn_s_barrier();                             \
        { const bool pf_ = ok1 && ok2; const int pk_ = pf_ ? k2 : ck, pn_ = pf_ ? n2 : cn; \
          int b2 = bc + 2; b2 = b2 >= 3 ? b2 - 3 : b2; \
          tile_dma(lds, b2, pk_ ? KS : KW, pk_ ? VS : VW, tbase + (size_t)(64 * pn_) * 256, w, lane); } \
        { const int b1 = bc + 1 >= 3 ? 0 : bc + 1; \
          sm_pv_tile(SC, lds + A_VT + bc * A_VT_SZ, O, mrun, lrun, ck, cn, i, tq, qv, slope2, selm, voff, ok1, lds + A_KT + b1 * A_KT_SZ, qf, AK, SN, r, h); } \
        if (!ok1 || k1 != ck) {       \
            const float lt = lrun + __shfl_xor(lrun, 32); const float sc = *(const LAS float*)(lds + A_GATE + tid * 8 + (ck ? 0 : 4)) * (lt > 0.f ? 1.f / lt : 0.f); \
            Oacc[0] = Oacc[0] + O[0] * sc; Oacc[1] = Oacc[1] + O[1] * sc; \
            mrun = -1e20f; lrun = 0.f; \
            _Pragma("unroll") for (int dt = 0; dt < 2; ++dt) _Pragma("unroll") for (int e = 0; e < 16; ++e) O[dt][e] = 0.f; \
        } \
        if (!ok1) break; \
        ck = k1; cn = n1; k1 = k2; n1 = n2; ok1 = ok2; { int k3, n3; bool ok3; TS_ADV(k2, n2, ok2, k3, n3, ok3); k2 = k3; n2 = n3; ok2 = ok3; } \
        bc = bc + 1 >= 3 ? 0 : bc + 1; }
    for (;;) {
        TILE_STEP(Sa, Sb)
        TILE_STEP(Sb, Sa)
    }
#undef TILE_STEP
#undef TS_ADV
    asm volatile("s_waitcnt vmcnt(0)" ::: "memory");
    __builtin_amdgcn_s_barrier();
    {
        LAS unsigned char* st = lds + (w < 5 ? w * 8704 : A_IMP + (w - 5) * 8704);
#pragma unroll
        for (int dt = 0; dt < 2; ++dt)
#pragma unroll
            for (int ig = 0; ig < 4; ++ig) { f32x4 v = {Oacc[dt][4 * ig], Oacc[dt][4 * ig + 1], Oacc[dt][4 * ig + 2], Oacc[dt][4 * ig + 3]};
                *(LAS f32x4*)(st + r * 272 + (32 * dt + 8 * ig + 4 * h) * 4) = v; }
        asm volatile("s_waitcnt lgkmcnt(0)" ::: "memory");
        const int qq = lane >> 3, dc = lane & 7;
#pragma unroll
        for (int j = 0; j < 4; ++j) { const int qr = 8 * j + qq;
            const size_t off = ((size_t)b * SEQ + 64 * i + 32 * qh + qr) * 1024 + head * 64 + dc * 8;
            const u32x4 z = *(const u32x4*)(SZN + off);
            const f32x4 o0 = *(const LAS f32x4*)(st + qr * 272 + dc * 32), o1 = *(const LAS f32x4*)(st + qr * 272 + dc * 32 + 16);
            u32x4 o; o.x = cvtpk(o0[0] * bf_lo(z.x), o0[1] * bf_hi(z.x)); o.y = cvtpk(o0[2] * bf_lo(z.y), o0[3] * bf_hi(z.y));
            o.z = cvtpk(o1[0] * bf_lo(z.z), o1[1] * bf_hi(z.z)); o.w = cvtpk(o1[2] * bf_lo(z.w), o1[3] * bf_hi(z.w));
            *(u32x4*)(AO + off) = o; }
    }
}

DI void phase_attn(const Args& a, LAS unsigned char* lds) {
    unsigned char* ws = a.ws; const int G = gridDim.x;
    const bf16_t* QB = (const bf16_t*)(ws + WS_QB); const bf16_t* KV = (const bf16_t*)(ws + WS_KV); const bf16_t* CMP = (const bf16_t*)(ws + WS_CMP);
    const bf16_t* SZN = (const bf16_t*)(ws + WS_SZN); const float* GT = (const float*)(ws + WS_GATE); bf16_t* AO = (bf16_t*)(ws + WS_XB);
    for (int k = 0;; ++k) {
        const long idx = (long)k * G + blockIdx.x; if (idx >= 2048) break;
        const int grp = (int)(idx >> 6), sub = (int)(idx & 63);
        const int per = G >> 6;
        int lvl = grp;
        if (per > 1 && (k & 1)) { const int base = (grp / per) * per; lvl = base + (per - 1 - (grp - base)); if (lvl > 31) lvl = grp; }
        const int i = 31 - lvl, b = sub >> 2, g = (sub + k) & 3;
        const long idx2 = (long)(k + 1) * G + blockIdx.x; const bool has_nx = idx2 < 2048; const int sub2 = (int)(idx2 & 63);
        attn_item(lds, QB, KV, CMP, SZN, GT, AO, b, i, g, k == 0, has_nx, sub2 >> 2, (sub2 + k + 1) & 3);
    }
}

constexpr int LDS_BYTES = 147456, LDS_CTL = 131072;
constexpr int N_PHASES = 12;
__global__ void __launch_bounds__(512, 2) fwd_kernel(Args a) {
    extern __shared__ __attribute__((aligned(16))) unsigned char lds_raw[];
    LAS unsigned char* lds = (LAS unsigned char*)lds_raw;
    unsigned char* ws = a.ws; const int G = gridDim.x, bid = blockIdx.x;
    const int lo = a.ph_lo, hi = a.ph_hi;
#define IN(k) (lo <= (k) && (k) < hi)
    if (threadIdx.x < 8) ((LAS unsigned*)(lds + LDS_CTL))[threadIdx.x] = 0u;
    __syncthreads();
    XcdBarrier bar = xcd_barrier_post((unsigned*)(ws + WS_CTL), (volatile LAS unsigned*)(lds + LDS_CTL));
#define SEAM(k) do { if (IN(k) && IN((k) + 1)) { if (hi > 4 * N_PHASES) cg::this_grid().sync(); else xcd_barrier(bar); } } while (0)
    const char* XB = (const char*)(ws + WS_XB);
    const bool wc_private = G >= 64;
    if (IN(0)) {
        if (wc_private) { if (bid < 32) wc_unit(a, lds, bid); phase_convert(a, lds, 32, false); }
        else phase_convert(a, lds, 0, true);
        phase_pool(a, bid, G);
    }
    SEAM(0);
    if (IN(1) && !wc_private) {
        const pg8::Geom g{512, 512, 2048, 128, 128, 128 * 512 * 2, 128 * 2048 * 2};
        SchedWc S{G, bid, (const char*)(ws + WS_WGT), (const char*)(ws + WS_WINB)};
        EpiWc E{(bf16_t*)(ws + WS_WCT), a.in[I_PSCALE]};
        pg8::gemm_phase<EpiWc, SchedWc, false>(lds, g, S, E);
    }
    if (!wc_private) SEAM(1);
    if (IN(2)) { const float* part = (const float*)(ws + WS_PART); float* gb = (float*)(ws + WS_GB);
        for (int e = bid * 512 + (int)threadIdx.x; e < 2 * NSA_PAD; e += G * 512) { const int which = e / NSA_PAD, c = e - which * NSA_PAD; float t = 0.f;
#pragma unroll 8
            for (int ks = 0; ks < 32; ++ks) t += part[(size_t)(ks * 2 + which) * NSA_PAD + c];
            gb[e] = t; } }
    if (IN(2)) {
        const pg8::Geom g{1024, 1024, 1024, 128, 128, 128 * 1024 * 2, 128 * 1024 * 2};
        SchedZU S{G, bid, XB, (const char*)(ws + WS_XP), (const char*)(ws + WS_WZT), (const char*)(ws + WS_WCT)};
        EpiZU E{(bf16_t*)(ws + WS_A), (bf16_t*)a.out + (size_t)bid * (256 * 256)};
        pg8::gemm_phase<EpiZU, SchedZU, true>(lds, g, S, E);
    }
    SEAM(2);
    if (IN(4)) {
        const pg8::Geom g{2048, 2048, 2048, 128, 128, 128 * 2048 * 2, 128 * 2048 * 2};
        SchedPlain S{MTOK / 256, 4, G, bid, (const char*)(ws + WS_A), (const char*)(ws + WS_WPOT), (size_t)256 * 2048 * 2, (size_t)256 * 2048 * 2};
        EpiRes0 E{(float*)(ws + WS_V), (bf16_t*)(ws + WS_XB), a.in[I_X], (float*)(ws + WS_STATS)};
        pg8::gemm_phase<EpiRes0, SchedPlain, true>(lds, g, S, E);
    }
    SEAM(4);
    if (IN(5)) { const float* ST = (const float*)(ws + WS_STATS); float* SF = (float*)(ws + WS_SF);
        for (int row = bid * 512 + (int)threadIdx.x; row < MTOK; row += G * 512) { const f32x4* p = (const f32x4*)(ST + (size_t)row * 32); float s_ = 0.f, q_ = 0.f;
#pragma unroll
            for (int j = 0; j < 8; ++j) { const f32x4 t = p[j]; s_ += t[0] + t[2]; q_ += t[1] + t[3]; }
            const float mean = s_ * (1.f / DM), var = q_ * (1.f / DM) - mean * mean; f32x2 o = {mean, 1.f / sqrtf(var + LN_EPS)}; *(f32x2*)(SF + (size_t)row * 2) = o; } }
    SEAM(5);
    if (IN(6)) {
        const pg8::Geom g{1024, 1024, 1024, 128, 128, 128 * 1024 * 2, 128 * 1024 * 2};
        EpiNsaIn E{(bf16_t*)(ws + WS_QB), (bf16_t*)(ws + WS_KV), (bf16_t*)(ws + WS_SZN), (float*)(ws + WS_GATE), (const float*)(ws + WS_SF), (const float*)(ws + WS_GB)};
        if (G == 256) { SchedNsaA S{G, bid, XB, (const char*)(ws + WS_WNIT)}; pg8::gemm_phase<EpiNsaIn, SchedNsaA, true>(lds, g, S, E); }
        else { SchedPlain S{MTOK / 256, NSA_PAD / 256, G, bid, XB, (const char*)(ws + WS_WNIT), (size_t)256 * 1024 * 2, (size_t)256 * 1024 * 2}; pg8::gemm_phase<EpiNsaIn, SchedPlain, true>(lds, g, S, E); }
    }
    SEAM(6);
    if (IN(7) && G == 256) {
        const pg8::Geom g{1024, 1024, 1024, 128, 128, 128 * 1024 * 2, 128 * 1024 * 2};
        EpiNsaIn E{(bf16_t*)(ws + WS_QB), (bf16_t*)(ws + WS_KV), (bf16_t*)(ws + WS_SZN), (float*)(ws + WS_GATE), (const float*)(ws + WS_SF), (const float*)(ws + WS_GB)};
        SchedNsaB S{bid, XB, (const char*)(ws + WS_WNIT)}; pg8::gemm_phase<EpiNsaIn, SchedNsaB, true>(lds, g, S, E);
    }
    if (IN(7)) {
        const pg8::Geom g{2048, 4096, 2048, 512, 128, 128, 128 * 2048 * 2};
        SchedCmp1 S{G, bid, (const char*)(ws + WS_KV), (const char*)(ws + WS_W1T)};
        EpiHid E{(bf16_t*)(ws + WS_HID), (const float*)(ws + WS_BIAS)};
        pg8::gemm_phase<EpiHid, SchedCmp1, false>(lds, g, S, E);
        asm volatile("s_waitcnt vmcnt(0)" ::: "memory"); __syncthreads();
    }
    if (IN(8)) {
        const pg8::Geom g{256, 256, 256, 128, 128, 128 * 256 * 2, 128 * 256 * 2};
        SchedCmp2 S{G, bid, (const char*)(ws + WS_HID), (const char*)(ws + WS_W2T)};
        EpiCmp E{(bf16_t*)(ws + WS_CMP)};
        pg8::gemm_phase<EpiCmp, SchedCmp2, false>(lds, g, S, E);
    }
    SEAM(8);
    if (IN(9)) phase_attn(a, lds);
    SEAM(9);
    if (IN(10)) {
        const pg8::Geom g{1024, 1024, 1024, 128, 128, 128 * 1024 * 2, 128 * 1024 * 2};
        SchedPlain S{MTOK / 256, 4, G, bid, XB, (const char*)(ws + WS_WNOT), (size_t)256 * 1024 * 2, (size_t)256 * 1024 * 2};
        EpiBf16 E{(bf16_t*)(ws + WS_QB)};
        pg8::gemm_phase<EpiBf16, SchedPlain, true>(lds, g, S, E);
    }
    SEAM(10);
    if (IN(11)) phase_final((const float*)(ws + WS_V), (const float*)(ws + WS_SF), (const bf16_t*)(ws + WS_QB), a.out, a.in[I_LNG], a.in[I_LNB]);
#undef IN
#undef SEAM
}

extern "C" void kernel_launch(void* const* d_in, const int* in_sizes, int n_in, void* d_out, int out_size, void* d_ws, size_t ws_size, hipStream_t stream) {
    static int grid = 0;
    if (grid == 0) {
        if (n_in != 15 || out_size != MTOK * DM || ws_size < WS_END) { fprintf(stderr, "kernel_launch: unexpected problem shape (n_in %d, out %d, ws %zu)\n", n_in, out_size, ws_size); grid = -1; return; }
        int dev = 0, cus = 0, per_cu = 0;
        if (hipGetDevice(&dev) != hipSuccess || hipDeviceGetAttribute(&cus, hipDeviceAttributeMultiprocessorCount, dev) != hipSuccess) { grid = -1; return; }
        if (hipFuncSetAttribute((const void*)fwd_kernel, hipFuncAttributeMaxDynamicSharedMemorySize, LDS_BYTES) != hipSuccess) { fprintf(stderr, "kernel_launch: hipFuncSetAttribute failed\n"); grid = -1; return; }
        if (hipOccupancyMaxActiveBlocksPerMultiprocessor(&per_cu, (const void*)fwd_kernel, 512, LDS_BYTES) != hipSuccess || per_cu < 1) per_cu = 1;
        (void)hipGetLastError();
        grid = cus * per_cu;
    }
    if (grid < 0) return;
    if (hipMemsetAsync((char*)d_ws + WS_CTL, 0, 16384, stream) != hipSuccess) { fprintf(stderr, "kernel_launch: memset failed\n"); return; }
    Args a{};
    for (int i = 0; i < 15; ++i) a.in[i] = (const float*)d_in[i];
    a.out = (float*)d_out; a.ws = (unsigned char*)d_ws;
#if MK_SINGLE
    a.ph_lo = 0; a.ph_hi = N_PHASES;
    void* args[] = {&a};
    hipError_t e = hipLaunchCooperativeKernel((const void*)fwd_kernel, dim3(grid), dim3(512), args, LDS_BYTES, stream);
    if (e != hipSuccess) fprintf(stderr, "cooperative launch failed: %s (grid %d)\n", hipGetErrorString(e), grid);
#else
    for (int p = 0; p < N_PHASES; ++p) { a.ph_lo = p; a.ph_hi = p + 1;
        const int reps = ((REP_MASK >> p) & 1) ? 2 : 1;
        for (int r = 0; r < reps; ++r) hipLaunchKernelGGL(fwd_kernel, dim3(grid), dim3(512), LDS_BYTES, stream, a); }
#endif
}
```
